# Optimizing an MI355X kernel written in HIP

```python
import math
import jax
import jax.numpy as jnp
from jax import lax
import numpy as np

D_MODEL = 1024
BATCH = 4
SEQ = 8192
DEPTH = 2

BLOCK = 128
N_BRANCH = 4
BRANCH_WIDTH = D_MODEL // 2

SWA_HEAD_DIM = 64
SWA_HEADS = BRANCH_WIDTH // SWA_HEAD_DIM
SWA_KV_HEADS = SWA_HEADS // 4
SWA_WINDOW = 128

SB_HEAD_DIM = 64
SB_HEADS = BRANCH_WIDTH // SB_HEAD_DIM

LRU_WIDTH = BRANCH_WIDTH
LRU_BLOCKS = 8
CONV_WIDTH = 4
LRU_C = 8.0

MEM_LEN = 256
MEM_HEADS = 4
MEM_HEAD_DIM = BRANCH_WIDTH // MEM_HEADS

EPS = 1e-6

SPLIT_SIZES = (
    SWA_HEADS * SWA_HEAD_DIM, SWA_KV_HEADS * SWA_HEAD_DIM, SWA_KV_HEADS * SWA_HEAD_DIM, BRANCH_WIDTH,
    BRANCH_WIDTH, BRANCH_WIDTH, BRANCH_WIDTH, BRANCH_WIDTH,
    LRU_WIDTH, LRU_WIDTH,
    BRANCH_WIDTH, BRANCH_WIDTH,
    N_BRANCH * D_MODEL,
)
IN_WIDTH = sum(SPLIT_SIZES)

kernel_name = "hybrid_gated_swa_stickbreak_rglru_mem"


def rms_norm(x, gain):
    xf = x.astype(jnp.float32)
    y = xf * lax.rsqrt(jnp.mean(xf * xf, axis=-1, keepdims=True) + EPS)
    return (y * gain.astype(jnp.float32)).astype(x.dtype)


def sliding_window_attention(q, k, v, sinks):
    b, s, h, d = q.shape
    kvh = k.shape[2]
    g = h // kvh
    nb = s // BLOCK
    qb = q.reshape(b, nb, BLOCK, kvh, g, d)

    def with_prev(t):
        tb = t.reshape(b, nb, BLOCK, kvh, d)
        prev = jnp.pad(tb[:, :-1], ((0, 0), (1, 0), (0, 0), (0, 0), (0, 0)))
        return jnp.concatenate([prev, tb], axis=2)

    kb, vb = with_prev(k), with_prev(v)
    scores = jnp.einsum('bnqkgd,bnskd->bkgnqs', qb, kb).astype(jnp.float32) * (d ** -0.5)
    qpos = jnp.arange(BLOCK)[:, None]
    kpos = jnp.arange(2 * BLOCK)[None, :] - BLOCK
    diff = qpos - kpos
    band = (diff >= 0) & (diff < SWA_WINDOW)
    key_abs = jnp.arange(nb)[:, None, None] * BLOCK + kpos[None]
    valid = band[None] & (key_abs >= 0)
    scores = jnp.where(valid, scores, -jnp.inf)
    sink = sinks.astype(jnp.float32).reshape(kvh, g)[None, :, :, None, None, None]
    m = jnp.maximum(jnp.max(scores, axis=-1, keepdims=True), sink)
    p = jnp.exp(scores - m)
    probs = p / (jnp.sum(p, axis=-1, keepdims=True) + jnp.exp(sink - m))
    out = jnp.einsum('bkgnqs,bnskd->bnqkgd', probs.astype(v.dtype), vb)
    return out.reshape(b, s, h, d)


def stick_breaking_attention(q, k, v):
    b, s, h, d = q.shape
    nb = s // BLOCK
    qb = q.reshape(b, nb, BLOCK, h, d).transpose(1, 0, 3, 2, 4)
    kpos = jnp.arange(s)
    scale = d ** -0.5

    def block(args):
        q_blk, n = args
        z = jnp.einsum('bhqd,bshd->bhqs', q_blk, k).astype(jnp.float32) * scale
        qpos = n * BLOCK + jnp.arange(BLOCK)
        causal = kpos[None, :] < qpos[:, None]
        log_keep = jnp.where(causal, jax.nn.log_sigmoid(-z), 0.0)
        between = lax.cumsum(log_keep, axis=3, reverse=True) - log_keep
        weights = jnp.where(causal, jnp.exp(jax.nn.log_sigmoid(z) + between), 0.0)
        return jnp.einsum('bhqs,bshd->bqhd', weights.astype(v.dtype), v)

    out = lax.map(block, (qb, jnp.arange(nb)))
    return out.transpose(1, 0, 2, 3, 4).reshape(b, s, h, d)


def causal_depthwise_conv(x, w, bias):
    c = x.shape[-1]
    y = lax.conv_general_dilated(x, w[:, None, :].astype(x.dtype), window_strides=(1,),
                                 padding=[(CONV_WIDTH - 1, 0)],
                                 dimension_numbers=('NWC', 'WIO', 'NWC'),
                                 feature_group_count=c)
    return y + bias


def rg_lru(x, w_a, b_a, w_x, b_x, lam):
    b, s, c = x.shape
    xb = x.reshape(b, s, LRU_BLOCKS, c // LRU_BLOCKS)
    r = jax.nn.sigmoid(jnp.einsum('bsnc,ncd->bsnd', xb, w_a).reshape(b, s, c) + b_a)
    i = jax.nn.sigmoid(jnp.einsum('bsnc,ncd->bsnd', xb, w_x).reshape(b, s, c) + b_x)
    log_a = -LRU_C * r.astype(jnp.float32) * jax.nn.softplus(-lam.astype(jnp.float32))
    a = jnp.exp(log_a)
    inp = jnp.sqrt(-jnp.expm1(2.0 * log_a)) * (i * x).astype(jnp.float32)

    def combine(left, right):
        a1, b1 = left
        a2, b2 = right
        return a1 * a2, a2 * b1 + b2

    _, h = lax.associative_scan(combine, (a, inp), axis=1)
    return h.astype(x.dtype)


def memory_attention(q, mk, mv):
    d = q.shape[-1]
    scores = jnp.einsum('bshd,bmhd->bhsm', q, mk).astype(jnp.float32) * (d ** -0.5)
    p = jax.nn.softmax(scores, axis=-1)
    return jnp.einsum('bhsm,bmhd->bshd', p.astype(mv.dtype), mv)


def hybrid_layer(x, mem, norm_gain, w_in, swa_q_gain, swa_k_gain, swa_sinks, conv_w, conv_b,
                 lru_w_a, lru_b_a, lru_w_x, lru_b_x, lru_lambda, mem_norm_gain, w_mem_kv,
                 mem_q_gain, mem_k_gain, w_branch, w_out):
    b, s, _ = x.shape
    u = rms_norm(x, norm_gain)
    proj = u @ w_in
    split_points = [int(p) for p in np.cumsum(SPLIT_SIZES)[:-1]]
    (a_q, a_k, a_v, a_g, b_q, b_k, b_v, b_g, c_x, c_g, m_q, m_g, merge) = jnp.split(proj, split_points, axis=-1)

    qa = rms_norm(a_q.reshape(b, s, SWA_HEADS, SWA_HEAD_DIM), swa_q_gain)
    ka = rms_norm(a_k.reshape(b, s, SWA_KV_HEADS, SWA_HEAD_DIM), swa_k_gain)
    va = a_v.reshape(b, s, SWA_KV_HEADS, SWA_HEAD_DIM)
    ya = sliding_window_attention(qa, ka, va, swa_sinks).reshape(b, s, BRANCH_WIDTH) * jax.nn.silu(a_g)

    yb = stick_breaking_attention(b_q.reshape(b, s, SB_HEADS, SB_HEAD_DIM),
                                  b_k.reshape(b, s, SB_HEADS, SB_HEAD_DIM),
                                  b_v.reshape(b, s, SB_HEADS, SB_HEAD_DIM)).reshape(b, s, BRANCH_WIDTH)
    yb = yb * jax.nn.silu(b_g)

    xc = causal_depthwise_conv(c_x, conv_w, conv_b)
    yc = rg_lru(xc, lru_w_a, lru_b_a, lru_w_x, lru_b_x, lru_lambda) * jax.nn.silu(c_g)

    mlen = mem.shape[1]
    mkv = rms_norm(mem, mem_norm_gain) @ w_mem_kv
    mk, mv = jnp.split(mkv, 2, axis=-1)
    mk = rms_norm(mk.reshape(b, mlen, MEM_HEADS, MEM_HEAD_DIM), mem_k_gain)
    mv = mv.reshape(b, mlen, MEM_HEADS, MEM_HEAD_DIM)
    qm = rms_norm(m_q.reshape(b, s, MEM_HEADS, MEM_HEAD_DIM), mem_q_gain)
    ym = memory_attention(qm, mk, mv).reshape(b, s, BRANCH_WIDTH) * jax.nn.silu(m_g)

    branches = jnp.stack([ya, yb, yc, ym], axis=2)
    up = jnp.einsum('bsnw,nwd->bsnd', branches, w_branch)
    gates = jax.nn.sigmoid(merge.reshape(b, s, N_BRANCH, D_MODEL))
    mixed = jnp.sum(gates * up, axis=2)
    return x + mixed @ w_out


def setup_inputs(seed: int = 0) -> dict:
    key = jax.random.key(seed)
    ks = jax.random.split(key, 24)
    f32 = jnp.float32
    hb = LRU_WIDTH // LRU_BLOCKS
    nrm = lambda k, shape, scale: jax.random.normal(k, shape, f32) * scale
    u = jax.random.uniform(ks[12], (DEPTH, LRU_WIDTH), f32, 0.9, 0.999)
    sig = u ** (1.0 / LRU_C)
    lru_lambda = jnp.log(sig) - jnp.log1p(-sig)
    return {
        'x': nrm(ks[0], (BATCH, SEQ, D_MODEL), 1.0),
        'mem': nrm(ks[1], (BATCH, MEM_LEN, D_MODEL), 1.0),
        'norm_gain': 1.0 + nrm(ks[2], (DEPTH, D_MODEL), 0.02),
        'w_in': nrm(ks[3], (DEPTH, D_MODEL, IN_WIDTH), D_MODEL ** -0.5),
        'swa_q_gain': 1.0 + nrm(ks[4], (DEPTH, SWA_HEAD_DIM), 0.02),
        'swa_k_gain': 1.0 + nrm(ks[5], (DEPTH, SWA_HEAD_DIM), 0.02),
        'swa_sinks': nrm(ks[6], (DEPTH, SWA_HEADS), 0.5),
        'conv_w': nrm(ks[7], (DEPTH, CONV_WIDTH, LRU_WIDTH), CONV_WIDTH ** -0.5),
        'conv_b': nrm(ks[8], (DEPTH, LRU_WIDTH), 0.01),
        'lru_w_a': nrm(ks[9], (DEPTH, LRU_BLOCKS, hb, hb), hb ** -0.5),
        'lru_b_a': nrm(ks[10], (DEPTH, LRU_WIDTH), 0.01),
        'lru_w_x': nrm(ks[11], (DEPTH, LRU_BLOCKS, hb, hb), hb ** -0.5),
        'lru_b_x': nrm(ks[13], (DEPTH, LRU_WIDTH), 0.01),
        'lru_lambda': lru_lambda,
        'mem_norm_gain': 1.0 + nrm(ks[14], (DEPTH, D_MODEL), 0.02),
        'w_mem_kv': nrm(ks[15], (DEPTH, D_MODEL, 2 * BRANCH_WIDTH), D_MODEL ** -0.5),
        'mem_q_gain': 1.0 + nrm(ks[16], (DEPTH, MEM_HEAD_DIM), 0.02),
        'mem_k_gain': 1.0 + nrm(ks[17], (DEPTH, MEM_HEAD_DIM), 0.02),
        'w_branch': nrm(ks[18], (DEPTH, N_BRANCH, BRANCH_WIDTH, D_MODEL), BRANCH_WIDTH ** -0.5),
        'w_out': nrm(ks[19], (DEPTH, D_MODEL, D_MODEL), D_MODEL ** -0.5),
    }


def reference(x, mem, norm_gain, w_in, swa_q_gain, swa_k_gain, swa_sinks, conv_w, conv_b,
              lru_w_a, lru_b_a, lru_w_x, lru_b_x, lru_lambda, mem_norm_gain, w_mem_kv,
              mem_q_gain, mem_k_gain, w_branch, w_out):
    for l in range(DEPTH):
        x = hybrid_layer(x, mem, norm_gain[l], w_in[l], swa_q_gain[l], swa_k_gain[l], swa_sinks[l],
                         conv_w[l], conv_b[l], lru_w_a[l], lru_b_a[l], lru_w_x[l], lru_b_x[l],
                         lru_lambda[l], mem_norm_gain[l], w_mem_kv[l], mem_q_gain[l], mem_k_gain[l],
                         w_branch[l], w_out[l])
    return x
```

```cpp
#include <hip/hip_runtime.h>
#include <hip/hip_cooperative_groups.h>
#include <cstdint>
#include <cstdio>
namespace cg = cooperative_groups;

#ifndef PM
#define PM 63
#endif
#ifndef COOP
#define COOP 1
#endif

typedef unsigned short bf16_t;
typedef short bf16x8 __attribute__((ext_vector_type(8)));
typedef float f32x4 __attribute__((ext_vector_type(4)));

constexpr int DM = 1024, BATCH = 4, SEQ = 8192, NTOK = BATCH * SEQ, INW = 9472;
constexpr int CB = 2, CT = CB * SEQ, NCHUNK = BATCH / CB;
constexpr int C_AQ = 0, C_AK = 512, C_AV = 640, C_AG = 768, C_BQ = 1280, C_BK = 1792, C_BV = 2304, C_BG = 2816,
              C_CX = 3328, C_CG = 3840, C_MQ = 4352, C_MG = 4864, C_MRG = 5376;
constexpr int LDS_BYTES = 131072;
constexpr float EPS = 1e-6f;
constexpr float LOG2E = 1.4426950408889634f;

struct Params {
  const float *x, *mem, *norm_gain, *w_in, *swa_q_gain, *swa_k_gain, *swa_sinks, *conv_w, *conv_b,
      *lru_w_a, *lru_b_a, *lru_w_x, *lru_b_x, *lru_lambda, *mem_norm_gain, *w_mem_kv,
      *mem_q_gain, *mem_k_gain, *w_branch, *w_out;
  float* out;
  bf16_t *WinT, *WbrT, *WoutT, *WmkvT, *xb, *memb, *mkv, *proj;
  float *ssq_x, *ssq_mem, *lruA, *lruH;
};

typedef const __attribute__((address_space(4))) Params* PP;
extern __shared__ __attribute__((aligned(16))) char smem[];
__device__ __forceinline__ int otid() { int t = threadIdx.x; asm volatile("" : "+v"(t)); return t; }

typedef __bf16 bf16v2 __attribute__((ext_vector_type(2)));
typedef float f32v2 __attribute__((ext_vector_type(2)));
__device__ __forceinline__ unsigned cvt_pk_bf16(float lo, float hi) {
  f32v2 v = {lo, hi};
  return __builtin_bit_cast(unsigned, __builtin_convertvector(v, bf16v2));
}
__device__ __forceinline__ bf16_t f2bf(float f) { return (bf16_t)(cvt_pk_bf16(f, 0.f) & 0xffffu); }
__device__ __forceinline__ float bf2f(bf16_t b) { return __uint_as_float(((unsigned)b) << 16); }
__device__ __forceinline__ float bflo(unsigned w) { return __uint_as_float(w << 16); }
__device__ __forceinline__ float bfhi(unsigned w) { return __uint_as_float(w & 0xffff0000u); }
__device__ __forceinline__ float fexp2(float x) { return __builtin_amdgcn_exp2f(x); }
__device__ __forceinline__ float flog2(float x) { return __builtin_amdgcn_logf(x); }
__device__ __forceinline__ float frcp(float x) { return __builtin_amdgcn_rcpf(x); }
__device__ __forceinline__ float sigmoidf_(float x) { return frcp(1.0f + fexp2(-x * LOG2E)); }
__device__ __forceinline__ float siluf_(float x) { return x * sigmoidf_(x); }

__device__ __forceinline__ int lds_byte(int r, int c) {
  int st = (r >> 4) * 2 + (c >> 5), rr = r & 15, cc = c & 31, ob = rr * 64 + cc * 2;
  return st * 1024 + (ob ^ (((ob >> 9) & 1) << 5));
}
__device__ __forceinline__ void stage_rc(int b, int& R, int& C) {
  int st = b / 1024, sb = b % 1024, swz = sb ^ (((sb >> 9) & 1) << 5);
  R = (st >> 1) * 16 + swz / 64; C = (st & 1) * 32 + (swz % 64) / 2;
}

#define WAIT_VN(N) asm volatile("s_waitcnt vmcnt(%0)" ::"n"(N) : "memory")
#define WAIT_L(n) asm volatile("s_waitcnt lgkmcnt(" #n ")" ::: "memory")
#define BAR __builtin_amdgcn_s_barrier()
#define SCHED __builtin_amdgcn_sched_barrier(0)

template <int AM>
__device__ __forceinline__ void gemm_kloop(const bf16_t* __restrict__ A, const int lda, const bf16_t* __restrict__ Bt,
                                           const int ldb, const int K, f32x4 (&acc)[2][2][AM][2]) {
  constexpr int LA = AM / 2, HA = 32 * AM;
  constexpr int W1 = 2 + LA, W2 = 4 + LA, W3 = LA;
  const int tid = otid(), wid = tid >> 6, lane = tid & 63, wr = wid >> 2, wc = wid & 3, fr = lane & 15, fq = lane >> 4;
  int aoff[LA], boff[2];
#pragma unroll
  for (int i = 0; i < LA; ++i) { int r, c; stage_rc(tid * 16 + i * 8192, r, c); aoff[i] = r * lda + c; }
#pragma unroll
  for (int i = 0; i < 2; ++i) { int r, c; stage_rc(tid * 16 + i * 8192, r, c); boff[i] = r * ldb + c; }
  const bf16_t* A0 = A; const bf16_t* A1 = A + (long)HA * lda;
  const bf16_t* B0p = Bt; const bf16_t* B1p = Bt + (long)128 * ldb;
#define SA_(b, h) (smem + ((b) * 2 + (h)) * 16384)
#define SB_(b, h) (smem + (4 + (b) * 2 + (h)) * 16384)
#define STG_A(b, h, kt) do { _Pragma("unroll") for (int _i = 0; _i < LA; ++_i) \
    __builtin_amdgcn_global_load_lds((const unsigned*)(((h) ? A1 : A0) + (kt) * 64 + aoff[_i]), (unsigned*)(SA_(b, h) + tid * 16 + _i * 8192), 16, 0, 0); } while (0)
#define STG_B(b, h, kt) do { _Pragma("unroll") for (int _i = 0; _i < 2; ++_i) \
    __builtin_amdgcn_global_load_lds((const unsigned*)(((h) ? B1p : B0p) + (kt) * 64 + boff[_i]), (unsigned*)(SB_(b, h) + tid * 16 + _i * 8192), 16, 0, 0); } while (0)
#define LDA_(dst, b, h) _Pragma("unroll") for (int m = 0; m < AM; ++m) _Pragma("unroll") for (int k = 0; k < 2; ++k) \
    dst[m][k] = *reinterpret_cast<const bf16x8*>(SA_(b, h) + lds_byte(wr * (16 * AM) + m * 16 + fr, k * 32 + fq * 8))
#define LDB_(dst, b, h) _Pragma("unroll") for (int n = 0; n < 2; ++n) _Pragma("unroll") for (int k = 0; k < 2; ++k) \
    dst[n][k] = *reinterpret_cast<const bf16x8*>(SB_(b, h) + lds_byte(wc * 32 + n * 16 + fr, k * 32 + fq * 8))
#define MMA_(ai, bj, At, Bx) do { __builtin_amdgcn_s_setprio(1); \
    _Pragma("unroll") for (int m = 0; m < AM; ++m) _Pragma("unroll") for (int n = 0; n < 2; ++n) _Pragma("unroll") for (int k = 0; k < 2; ++k) \
      acc[ai][bj][m][n] = __builtin_amdgcn_mfma_f32_16x16x32_bf16(Bx[n][k], At[m][k], acc[ai][bj][m][n], 0, 0, 0); \
    __builtin_amdgcn_s_setprio(0); } while (0)

  bf16x8 At[AM][2], Bf0[2][2], Bf1[2][2];
  const int nt = K / 64;
  STG_B(0, 0, 0); STG_A(0, 0, 0); STG_B(0, 1, 0); STG_A(0, 1, 0);
  if (wr == 1) BAR;
  WAIT_VN(W1); BAR;
  STG_B(1, 0, 1); STG_A(1, 0, 1); STG_B(1, 1, 1);
  WAIT_VN(W2); BAR;
  for (int t = 0; t < nt - 2; t += 2) {
    LDB_(Bf0, 0, 0); SCHED; LDA_(At, 0, 0); STG_A(1, 1, t + 1);
    WAIT_L(8); BAR; WAIT_L(0); MMA_(0, 0, At, Bf0); BAR; SCHED;
    LDB_(Bf1, 0, 1); STG_B(0, 0, t + 2);
    BAR; WAIT_L(0); MMA_(0, 1, At, Bf1); BAR;
    LDA_(At, 0, 1); STG_A(0, 0, t + 2);
    BAR; WAIT_L(0); MMA_(1, 0, At, Bf0); BAR; SCHED;
    STG_B(0, 1, t + 2);
    WAIT_VN(W2); BAR; MMA_(1, 1, At, Bf1); BAR;
    LDB_(Bf0, 1, 0); SCHED; LDA_(At, 1, 0); STG_A(0, 1, t + 2);
    WAIT_L(8); BAR; WAIT_L(0); MMA_(0, 0, At, Bf0); BAR; SCHED;
    LDB_(Bf1, 1, 1); STG_B(1, 0, t + 3);
    BAR; WAIT_L(0); MMA_(0, 1, At, Bf1); BAR;
    LDA_(At, 1, 1); STG_A(1, 0, t + 3);
    BAR; WAIT_L(0); MMA_(1, 0, At, Bf0); BAR; SCHED;
    STG_B(1, 1, t + 3);
    WAIT_VN(W2); BAR; MMA_(1, 1, At, Bf1); BAR;
  }
  { LDB_(Bf0, 0, 0); LDA_(At, 0, 0); STG_A(1, 1, nt - 1);
    BAR; WAIT_L(0); MMA_(0, 0, At, Bf0); BAR;
    LDB_(Bf1, 0, 1); BAR; WAIT_L(0); MMA_(0, 1, At, Bf1); BAR;
    LDA_(At, 0, 1); WAIT_VN(W1); BAR; WAIT_L(0); MMA_(1, 0, At, Bf0); MMA_(1, 1, At, Bf1); BAR; }
  { LDB_(Bf0, 1, 0); LDA_(At, 1, 0); WAIT_VN(W3); BAR; WAIT_L(0); MMA_(0, 0, At, Bf0); BAR;
    LDB_(Bf1, 1, 1); WAIT_VN(0); BAR; WAIT_L(0); MMA_(0, 1, At, Bf1); BAR;
    LDA_(At, 1, 1); BAR; WAIT_L(0); MMA_(1, 0, At, Bf0); MMA_(1, 1, At, Bf1); BAR; }
  if (wr == 0) BAR;
}

__device__ __forceinline__ void tile_remap(int L, int nM, int nN, int& pm, int& pn) {
  const int nwg = nM * nN; int wgid = L;
  const int q = nwg / 8, r = nwg % 8, xcd = wgid % 8, off = wgid / 8;
  wgid = (xcd < r ? xcd * (q + 1) : r * (q + 1) + (xcd - r) * q) + off;
  const int nig = 8 * nN, gid = wgid / nig, fm = gid * 8, gsz = min(nM - fm, 8);
  pm = fm + ((wgid % nig) % gsz); pn = (wgid % nig) / gsz;
}

__device__ __forceinline__ void transpose_tile(const float* __restrict__ src, int N, bf16_t* __restrict__ dst, int K,
                                               int k0, int n0, const float* __restrict__ scale) {
  float* tile = (float*)smem;
  const int tid = otid();
  __syncthreads();
#pragma unroll
  for (int e = tid; e < 4096; e += 512) {
    int kk = e >> 6, nn = e & 63;
    float v = src[(long)(k0 + kk) * N + n0 + nn];
    if (scale) v *= scale[k0 + kk];
    tile[kk * 65 + nn] = v;
  }
  __syncthreads();
#pragma unroll
  for (int e = tid; e < 4096; e += 512) {
    int nn = e >> 6, kk = e & 63;
    dst[(long)(n0 + nn) * K + k0 + kk] = f2bf(tile[kk * 65 + nn]);
  }
}

__device__ void phase_prep(PP p) {
  const int tid = otid(), wid = tid >> 6, lane = tid & 63;
  constexpr int U_IN = 16 * 148, U_BR = 8 * 16, U_SQ = 16 * 16;
  constexpr int NU = 2 * U_IN + 8 * U_BR + 2 * U_SQ + 2 * U_SQ;
  for (int u = blockIdx.x; u < NU; u += gridDim.x) {
    if (u < 2 * U_IN) {
      int l = u / U_IN, v = u % U_IN, kt = v / 148, nt = v % 148;
      transpose_tile(p->w_in + (long)l * DM * INW, INW, p->WinT + (long)l * INW * DM, DM, kt * 64, nt * 64, p->norm_gain + l * DM);
    } else if (u < 2 * U_IN + 8 * U_BR) {
      int v = u - 2 * U_IN, ln = v / U_BR, w = v % U_BR, kt = w / 16, nt = w % 16;
      transpose_tile(p->w_branch + (long)ln * 512 * DM, DM, p->WbrT + (long)ln * DM * 512, 512, kt * 64, nt * 64, nullptr);
    } else if (u < 2 * U_IN + 8 * U_BR + 2 * U_SQ) {
      int v = u - (2 * U_IN + 8 * U_BR), l = v / U_SQ, w = v % U_SQ, kt = w / 16, nt = w % 16;
      transpose_tile(p->w_out + (long)l * DM * DM, DM, p->WoutT + (long)l * DM * DM, DM, kt * 64, nt * 64, nullptr);
    } else {
      int v = u - (2 * U_IN + 8 * U_BR + 2 * U_SQ), l = v / U_SQ, w = v % U_SQ, kt = w / 16, nt = w % 16;
      transpose_tile(p->w_mem_kv + (long)l * DM * DM, DM, p->WmkvT + (long)l * DM * DM, DM, kt * 64, nt * 64, p->mem_norm_gain + l * DM);
    }
  }
  for (int r = blockIdx.x * 8 + wid; r < NTOK + BATCH * 256; r += gridDim.x * 8) {
    const float* src; bf16_t* dst; float* sq;
    if (r < NTOK) { src = p->x + (long)r * DM; dst = p->xb + (long)r * DM; sq = p->ssq_x + r; }
    else { int m = r - NTOK; src = p->mem + (long)m * DM; dst = p->memb + (long)m * DM; sq = p->ssq_mem + m; }
    float ss = 0.f;
#pragma unroll
    for (int i = 0; i < 4; ++i) {
      float4 v = *(const float4*)(src + (i * 64 + lane) * 4);
      ss += v.x * v.x + v.y * v.y + v.z * v.z + v.w * v.w;
      uint2 pk; pk.x = cvt_pk_bf16(v.x, v.y); pk.y = cvt_pk_bf16(v.z, v.w);
      *(uint2*)(dst + (i * 64 + lane) * 4) = pk;
    }
#pragma unroll
    for (int o = 32; o >= 1; o >>= 1) ss += __shfl_xor(ss, o);
    if (lane == 0) *sq = ss;
  }
  for (int i = blockIdx.x * 512 + tid; i < NTOK; i += gridDim.x * 512) p->ssq_x[NTOK + i] = 0.f;
}

__device__ void phase_g1(PP p, int c, int l) {
  const int tid = otid(), wid = tid >> 6, lane = tid & 63, wr = wid >> 2, wc = wid & 3, fr = lane & 15, fq = lane >> 4;
  constexpr int nM = CT / 256, nN = INW / 256, NT1 = nM * nN;
  const int ntiles = NT1 + ((c == 0 && l == 0) ? 32 : 0);
  for (int i = blockIdx.x; i < ntiles; i += gridDim.x) {
    const bf16_t *A, *Bt; const float* ssq; bf16_t* out; int ldo;
    if (i < NT1) {
      int pm, pn; tile_remap(i, nM, nN, pm, pn);
      A = p->xb + ((long)c * CT + pm * 256) * DM; Bt = p->WinT + ((long)l * INW + pn * 256) * DM;
      ssq = p->ssq_x + (long)l * NTOK + c * CT + pm * 256; out = p->proj + (long)pm * 256 * INW + pn * 256; ldo = INW;
    } else {
      int j = i - NT1, ll = j >> 4, pm = (j & 15) >> 2, pn = j & 3;
      A = p->memb + (long)pm * 256 * DM; Bt = p->WmkvT + ((long)ll * DM + pn * 256) * DM;
      ssq = p->ssq_mem + pm * 256; out = p->mkv + ((long)ll * 1024 + pm * 256) * DM + pn * 256; ldo = DM;
    }
    f32x4 acc[2][2][4][2];
#pragma unroll
    for (int a = 0; a < 2; ++a)
#pragma unroll
      for (int b = 0; b < 2; ++b)
#pragma unroll
        for (int m = 0; m < 4; ++m)
#pragma unroll
          for (int n = 0; n < 2; ++n) acc[a][b][m][n] = f32x4{0.f, 0.f, 0.f, 0.f};
    gemm_kloop<4>(A, DM, Bt, DM, DM, acc);
#pragma unroll
    for (int ai = 0; ai < 2; ++ai)
#pragma unroll
      for (int m = 0; m < 4; ++m) {
        const int r = ai * 128 + wr * 64 + m * 16 + fr;
        const float rs = rsqrtf(ssq[r] * (1.0f / DM) + EPS);
        bf16_t* o = out + (long)r * ldo + wc * 32 + fq * 4;
#pragma unroll
        for (int bj = 0; bj < 2; ++bj)
#pragma unroll
          for (int n = 0; n < 2; ++n) {
            f32x4 v = acc[ai][bj][m][n];
            uint2 pk; pk.x = cvt_pk_bf16(v[0] * rs, v[1] * rs); pk.y = cvt_pk_bf16(v[2] * rs, v[3] * rs);
            *(uint2*)(o + bj * 128 + n * 16) = pk;
          }
      }
  }
}

__device__ void phase_g2(PP p, int c, int l) {
  const int tid = otid(), wid = tid >> 6, lane = tid & 63, wr = wid >> 2, wc = wid & 3, fr = lane & 15, fq = lane >> 4;
  constexpr int NT = (CT / 128) * 4;
  for (int i = blockIdx.x; i < NT; i += gridDim.x) {
    const int pm = i >> 2, pn = i & 3;
    f32x4 mix[2][2][2][2];
#pragma unroll
    for (int a = 0; a < 2; ++a)
#pragma unroll
      for (int b = 0; b < 2; ++b)
#pragma unroll
        for (int m = 0; m < 2; ++m)
#pragma unroll
          for (int n = 0; n < 2; ++n) mix[a][b][m][n] = f32x4{0.f, 0.f, 0.f, 0.f};
    bf16_t* prow = p->proj + (long)pm * 128 * INW;
#pragma unroll 1
    for (int n4 = 0; n4 < 4; ++n4) {
      const int bcol = (n4 == 0) ? C_AQ : (n4 == 1) ? C_BQ : (n4 == 2) ? C_CG : C_MQ;
      f32x4 acc[2][2][2][2];
#pragma unroll
      for (int a = 0; a < 2; ++a)
#pragma unroll
        for (int b = 0; b < 2; ++b)
#pragma unroll
          for (int m = 0; m < 2; ++m)
#pragma unroll
            for (int n = 0; n < 2; ++n) acc[a][b][m][n] = f32x4{0.f, 0.f, 0.f, 0.f};
      gemm_kloop<2>(prow + bcol, INW, p->WbrT + ((long)(l * 4 + n4) * DM + pn * 256) * 512, 512, 512, acc);
#pragma unroll
      for (int ai = 0; ai < 2; ++ai)
#pragma unroll
        for (int m = 0; m < 2; ++m) {
          const int r = ai * 64 + wr * 32 + m * 16 + fr;
          const bf16_t* g = prow + (long)r * INW + C_MRG + n4 * DM + pn * 256 + wc * 32 + fq * 4;
#pragma unroll
          for (int bj = 0; bj < 2; ++bj)
#pragma unroll
            for (int n = 0; n < 2; ++n) {
              uint2 gv = *(const uint2*)(g + bj * 128 + n * 16);
              f32x4 v = acc[ai][bj][m][n];
              mix[ai][bj][m][n][0] += sigmoidf_(bflo(gv.x)) * v[0];
              mix[ai][bj][m][n][1] += sigmoidf_(bfhi(gv.x)) * v[1];
              mix[ai][bj][m][n][2] += sigmoidf_(bflo(gv.y)) * v[2];
              mix[ai][bj][m][n][3] += sigmoidf_(bfhi(gv.y)) * v[3];
            }
        }
    }
#pragma unroll
    for (int ai = 0; ai < 2; ++ai)
#pragma unroll
      for (int m = 0; m < 2; ++m) {
        const int r = ai * 64 + wr * 32 + m * 16 + fr;
        bf16_t* o = prow + (long)r * INW + C_MRG + pn * 256 + wc * 32 + fq * 4;
#pragma unroll
        for (int bj = 0; bj < 2; ++bj)
#pragma unroll
          for (int n = 0; n < 2; ++n) {
            f32x4 v = mix[ai][bj][m][n];
            uint2 pk; pk.x = cvt_pk_bf16(v[0], v[1]); pk.y = cvt_pk_bf16(v[2], v[3]);
            *(uint2*)(o + bj * 128 + n * 16) = pk;
          }
      }
  }
}

__device__ void phase_g3(PP p, int c, int l) {
  const int tid = otid(), wid = tid >> 6, lane = tid & 63, wr = wid >> 2, wc = wid & 3, fr = lane & 15, fq = lane >> 4;
  constexpr int NT = (CT / 256) * 4;
  for (int i = blockIdx.x; i < NT; i += gridDim.x) {
    const int pm = i >> 2, pn = i & 3;
    f32x4 acc[2][2][4][2];
#pragma unroll
    for (int a = 0; a < 2; ++a)
#pragma unroll
      for (int b = 0; b < 2; ++b)
#pragma unroll
        for (int m = 0; m < 4; ++m)
#pragma unroll
          for (int n = 0; n < 2; ++n) acc[a][b][m][n] = f32x4{0.f, 0.f, 0.f, 0.f};
    gemm_kloop<4>(p->proj + (long)pm * 256 * INW + C_MRG, INW, p->WoutT + ((long)l * DM + pn * 256) * DM, DM, DM, acc);
    const float* xold = (l == 0) ? p->x : p->out;
#pragma unroll
    for (int ai = 0; ai < 2; ++ai)
#pragma unroll
      for (int m = 0; m < 4; ++m) {
        const long gr = (long)c * CT + pm * 256 + ai * 128 + wr * 64 + m * 16 + fr;
        const long base = gr * DM + pn * 256 + wc * 32 + fq * 4;
        float ss = 0.f;
#pragma unroll
        for (int bj = 0; bj < 2; ++bj)
#pragma unroll
          for (int n = 0; n < 2; ++n) {
            const long off = base + bj * 128 + n * 16;
            float4 xo = *(const float4*)(xold + off);
            f32x4 v = acc[ai][bj][m][n];
            float4 xn; xn.x = xo.x + v[0]; xn.y = xo.y + v[1]; xn.z = xo.z + v[2]; xn.w = xo.w + v[3];
            *(float4*)(p->out + off) = xn;
            if (l == 0) {
              uint2 pk; pk.x = cvt_pk_bf16(xn.x, xn.y); pk.y = cvt_pk_bf16(xn.z, xn.w);
              *(uint2*)(p->xb + off) = pk;
              ss += xn.x * xn.x + xn.y * xn.y + xn.z * xn.z + xn.w * xn.w;
            }
          }
        if (l == 0) {
          ss += __shfl_xor(ss, 16); ss += __shfl_xor(ss, 32);
          if (fq == 0) atomicAdd(p->ssq_x + NTOK + gr, ss);
        }
      }
  }
}

template <int D, int MODE>
__device__ void attn_item(PP p, int c, int l, int bb, int qb, int h) {
  constexpr int KP = D + 8, VP = 132, NKS = D / 32, NDS = D / 16;
  constexpr int TPR = D / 8, RPP = 512 / TPR, NP = 128 / RPP;
  bf16_t* Ks = (bf16_t*)smem;
  bf16_t* Vt = (bf16_t*)(smem + 128 * KP * 2);
  int* flags = (int*)(smem + 128 * KP * 2 + D * VP * 2);
  const int tid = otid(), wid = tid >> 6, lane = tid & 63, fr = lane & 15, fq = lane >> 4;
  const float sc = LOG2E * (D == 64 ? 0.125f : 0.08838834764831845f);
  const int qcol = (MODE == 0 ? C_AQ : MODE == 1 ? C_BQ : C_MQ) + h * D;
  const int gcol = (MODE == 0 ? C_AG : MODE == 1 ? C_BG : C_MG) + h * D;
  const long rowQ = (long)bb * SEQ + qb * 128 + wid * 16 + fr;
  bf16_t* qptr = p->proj + rowQ * INW + qcol;
  const int qi = wid * 16 + fr;

  bf16x8 qf[NKS];
  {
    float qv[NKS][8]; float ss = 0.f;
#pragma unroll
    for (int ks = 0; ks < NKS; ++ks) {
      uint4 u = *(const uint4*)(qptr + ks * 32 + fq * 8);
      qv[ks][0] = bflo(u.x); qv[ks][1] = bfhi(u.x); qv[ks][2] = bflo(u.y); qv[ks][3] = bfhi(u.y);
      qv[ks][4] = bflo(u.z); qv[ks][5] = bfhi(u.z); qv[ks][6] = bflo(u.w); qv[ks][7] = bfhi(u.w);
#pragma unroll
      for (int i = 0; i < 8; ++i) ss += qv[ks][i] * qv[ks][i];
    }
    float rs = sc;
    const float* qg = (MODE == 0) ? (p->swa_q_gain + l * 64) : (p->mem_q_gain + l * 128);
    if (MODE != 1) {
      ss += __shfl_xor(ss, 16); ss += __shfl_xor(ss, 32);
      rs = rsqrtf(ss * (1.0f / D) + EPS) * sc;
    }
#pragma unroll
    for (int ks = 0; ks < NKS; ++ks) {
      float g[8];
#pragma unroll
      for (int i = 0; i < 8; ++i) g[i] = (MODE != 1) ? qg[ks * 32 + fq * 8 + i] * rs : rs;
      union { unsigned u[4]; bf16x8 v; } cv;
#pragma unroll
      for (int i = 0; i < 4; ++i) cv.u[i] = cvt_pk_bf16(qv[ks][2 * i] * g[2 * i], qv[ks][2 * i + 1] * g[2 * i + 1]);
      qf[ks] = cv.v;
    }
  }

  bf16x8 uop[2];
  if (MODE == 1) {
#pragma unroll
    for (int ss_ = 0; ss_ < 2; ++ss_) {
      const int srow = ss_ * 16 + fr;
#pragma unroll
      for (int i = 0; i < 8; ++i) {
        const int j = (i < 4) ? (4 * fq + i) : (16 + 4 * fq + (i - 4));
        uop[ss_][i] = (j >= srow) ? (short)0x3F80 : (short)0;
      }
    }
  }

  f32x4 o[NDS];
#pragma unroll
  for (int d = 0; d < NDS; ++d) o[d] = f32x4{0.f, 0.f, 0.f, 0.f};
  float m_run = -1e30f, lsum = 0.f, R = 0.f;
  if (MODE == 0) m_run = p->swa_sinks[l * 8 + h] * LOG2E;

  const bf16_t *Kbase, *Vbase; int ldk; const float* kg = nullptr;
  if (MODE == 0) { Kbase = p->proj + (long)bb * SEQ * INW + C_AK + (h >> 2) * 64; Vbase = p->proj + (long)bb * SEQ * INW + C_AV + (h >> 2) * 64; ldk = INW; kg = p->swa_k_gain + l * 64; }
  else if (MODE == 1) { Kbase = p->proj + (long)bb * SEQ * INW + C_BK + h * 64; Vbase = p->proj + (long)bb * SEQ * INW + C_BV + h * 64; ldk = INW; }
  else { const int gb = c * CB + bb; Kbase = p->mkv + ((long)l * 1024 + gb * 256) * DM + h * 128; Vbase = Kbase + 512; ldk = DM; kg = p->mem_k_gain + l * 128; }

  const int ntile_max = (MODE == 0) ? 2 : (MODE == 2) ? 2 : (qb + 1);
#pragma unroll 1
  for (int tj = 0; tj < ntile_max; ++tj) {
    int krow0; bool diag = false, prev = false;
    if (MODE == 0) { if (tj == 0) { if (qb == 0) continue; krow0 = qb * 128 - 128; prev = true; } else { krow0 = qb * 128; diag = true; } }
    else if (MODE == 1) { krow0 = (qb - tj) * 128; diag = (tj == 0); }
    else { krow0 = tj * 128; }
    __syncthreads();
#pragma unroll
    for (int ps = 0; ps < NP; ++ps) {
      const int r = ps * RPP + tid / TPR, cc = tid % TPR;
      uint4 u = *(const uint4*)(Kbase + (long)(krow0 + r) * ldk + cc * 8);
      if (MODE != 1) {
        float f[8] = {bflo(u.x), bfhi(u.x), bflo(u.y), bfhi(u.y), bflo(u.z), bfhi(u.z), bflo(u.w), bfhi(u.w)};
        float ss = 0.f;
#pragma unroll
        for (int i = 0; i < 8; ++i) ss += f[i] * f[i];
#pragma unroll
        for (int off = 1; off < TPR; off <<= 1) ss += __shfl_xor(ss, off);
        const float rs = rsqrtf(ss * (1.0f / D) + EPS);
#pragma unroll
        for (int i = 0; i < 8; ++i) f[i] *= rs * kg[cc * 8 + i];
        u.x = cvt_pk_bf16(f[0], f[1]); u.y = cvt_pk_bf16(f[2], f[3]); u.z = cvt_pk_bf16(f[4], f[5]); u.w = cvt_pk_bf16(f[6], f[7]);
      }
      *(uint4*)(Ks + r * KP + cc * 8) = u;
      uint4 v = *(const uint4*)(Vbase + (long)(krow0 + r) * ldk + cc * 8);
      bf16_t* vd = Vt + (cc * 8) * VP + r;
      vd[0 * VP] = (bf16_t)(v.x & 0xffff); vd[1 * VP] = (bf16_t)(v.x >> 16);
      vd[2 * VP] = (bf16_t)(v.y & 0xffff); vd[3 * VP] = (bf16_t)(v.y >> 16);
      vd[4 * VP] = (bf16_t)(v.z & 0xffff); vd[5 * VP] = (bf16_t)(v.z >> 16);
      vd[6 * VP] = (bf16_t)(v.w & 0xffff); vd[7 * VP] = (bf16_t)(v.w >> 16);
    }
    __syncthreads();

#pragma unroll 1
    for (int gg = 0; gg < 4; ++gg) {
      const int g = (MODE == 1) ? (3 - gg) : gg;
      if (diag && g * 32 > wid * 16 + 15) continue;
      if (prev && g * 32 + 31 <= wid * 16) continue;
      f32x4 s[2];
#pragma unroll
      for (int sub = 0; sub < 2; ++sub) {
        s[sub] = f32x4{0.f, 0.f, 0.f, 0.f};
#pragma unroll
        for (int ks = 0; ks < NKS; ++ks) {
          bf16x8 a = *(const bf16x8*)(Ks + (g * 32 + sub * 16 + fr) * KP + ks * 32 + fq * 8);
          s[sub] = __builtin_amdgcn_mfma_f32_16x16x32_bf16(a, qf[ks], s[sub], 0, 0, 0);
        }
      }
      float w[8];
      if (MODE == 1) {
        float Lv[8], tot = 0.f; bool vld[8];
#pragma unroll
        for (int i = 0; i < 8; ++i) {
          const int kk = g * 32 + (i >> 2) * 16 + fq * 4 + (i & 3);
          vld[i] = !diag || (kk < qi);
          const float z2 = s[i >> 2][i & 3];
          const float lv = -(fmaxf(z2, 0.f) + flog2(1.0f + fexp2(-fabsf(z2))));
          Lv[i] = vld[i] ? lv : 0.f;
          tot += Lv[i];
        }
        tot += __shfl_xor(tot, 16); tot += __shfl_xor(tot, 32);
        union { unsigned u[4]; bf16x8 v; } hi, lo;
#pragma unroll
        for (int i = 0; i < 4; ++i) {
          const unsigned hp = cvt_pk_bf16(Lv[2 * i], Lv[2 * i + 1]);
          hi.u[i] = hp;
          lo.u[i] = cvt_pk_bf16(Lv[2 * i] - bflo(hp), Lv[2 * i + 1] - bfhi(hp));
        }
        f32x4 cs[2];
#pragma unroll
        for (int ss_ = 0; ss_ < 2; ++ss_) {
          cs[ss_] = f32x4{0.f, 0.f, 0.f, 0.f};
          cs[ss_] = __builtin_amdgcn_mfma_f32_16x16x32_bf16(uop[ss_], hi.v, cs[ss_], 0, 0, 0);
          cs[ss_] = __builtin_amdgcn_mfma_f32_16x16x32_bf16(uop[ss_], lo.v, cs[ss_], 0, 0, 0);
        }
#pragma unroll
        for (int i = 0; i < 8; ++i) {
          const float e = s[i >> 2][i & 3] + cs[i >> 2][i & 3] + R;
          w[i] = vld[i] ? fexp2(e) : 0.f;
        }
        R += tot;
      } else {
        float gmax = -1e30f;
#pragma unroll
        for (int i = 0; i < 8; ++i) {
          const int kk = g * 32 + (i >> 2) * 16 + fq * 4 + (i & 3);
          bool v = true;
          if (MODE == 0) v = diag ? (kk <= qi) : (kk > qi);
          w[i] = v ? s[i >> 2][i & 3] : -1e30f;
          gmax = fmaxf(gmax, w[i]);
        }
        gmax = fmaxf(gmax, __shfl_xor(gmax, 16)); gmax = fmaxf(gmax, __shfl_xor(gmax, 32));
        const float m_new = fmaxf(m_run, gmax);
        const float alpha = fexp2(m_run - m_new);
        float ps = 0.f;
#pragma unroll
        for (int i = 0; i < 8; ++i) { w[i] = fexp2(w[i] - m_new); ps += w[i]; }
        lsum = lsum * alpha + ps;
#pragma unroll
        for (int d = 0; d < NDS; ++d) { o[d][0] *= alpha; o[d][1] *= alpha; o[d][2] *= alpha; o[d][3] *= alpha; }
        m_run = m_new;
      }
      union { unsigned u[4]; bf16x8 v; } wb;
#pragma unroll
      for (int i = 0; i < 4; ++i) wb.u[i] = cvt_pk_bf16(w[2 * i], w[2 * i + 1]);
#pragma unroll
      for (int d = 0; d < NDS; ++d) {
        const bf16_t* vp = Vt + (d * 16 + fr) * VP + g * 32 + 4 * fq;
        union { uint2 h[2]; bf16x8 v; } a;
        a.h[0] = *(const uint2*)vp; a.h[1] = *(const uint2*)(vp + 16);
        o[d] = __builtin_amdgcn_mfma_f32_16x16x32_bf16(a.v, wb.v, o[d], 0, 0, 0);
      }
    }
    if (MODE == 1) {
      const int okw = __all(R < -150.0f);
      __syncthreads();
      if (lane == 0) flags[wid] = okw;
      __syncthreads();
      int all = 1;
#pragma unroll
      for (int i = 0; i < 8; ++i) all &= flags[i];
      if (all) break;
    }
  }

  float inv = 1.0f;
  if (MODE != 1) {
    lsum += __shfl_xor(lsum, 16); lsum += __shfl_xor(lsum, 32);
    if (MODE == 0) lsum += fexp2(p->swa_sinks[l * 8 + h] * LOG2E - m_run);
    inv = 1.0f / lsum;
  }
  const bf16_t* gp = p->proj + rowQ * INW + gcol + 4 * fq;
#pragma unroll
  for (int d = 0; d < NDS; ++d) {
    uint2 gv = *(const uint2*)(gp + d * 16);
    uint2 pk;
    pk.x = cvt_pk_bf16(o[d][0] * inv * siluf_(bflo(gv.x)), o[d][1] * inv * siluf_(bfhi(gv.x)));
    pk.y = cvt_pk_bf16(o[d][2] * inv * siluf_(bflo(gv.y)), o[d][3] * inv * siluf_(bfhi(gv.y)));
    *(uint2*)(qptr + d * 16 + 4 * fq) = pk;
  }
}

template <int APPLY>
__device__ void lru_item(PP p, int l, int bb, int ck, int nb) {
  bf16_t* cxs = (bf16_t*)smem;
  bf16_t* xcs = (bf16_t*)(smem + 16896);
  bf16_t* wta = (bf16_t*)(smem + 35328);
  bf16_t* wtx = (bf16_t*)(smem + 44544);
  float* as_ = (float*)(smem + 53760);
  float* bs_ = (float*)(smem + 86528);
  float* segA = (float*)(smem + 119296);
  float* segH = (float*)(smem + 121344);
  float* cin = (float*)(smem + 123392);
  const int tid = otid(), wid = tid >> 6, lane = tid & 63, fr = lane & 15, fq = lane >> 4;
  const long row0 = (long)bb * SEQ + ck * 128;
  __syncthreads();
  for (int s = tid; s < 131 * 8; s += 512) {
    const int r = s >> 3, cc = s & 7, t = ck * 128 + r - 3;
    uint4 u = make_uint4(0, 0, 0, 0);
    if (t >= 0) u = *(const uint4*)(p->proj + ((long)bb * SEQ + t) * INW + C_CX + nb * 64 + cc * 8);
    *(uint4*)(cxs + r * 64 + cc * 8) = u;
  }
  {
    const float* wa = p->lru_w_a + (long)(l * 8 + nb) * 4096;
    const float* wx = p->lru_w_x + (long)(l * 8 + nb) * 4096;
#pragma unroll
    for (int e = tid; e < 1024; e += 512) {
      const int cch = e >> 4, d4 = (e & 15) * 4;
      float4 va = *(const float4*)(wa + cch * 64 + d4);
      float4 vx = *(const float4*)(wx + cch * 64 + d4);
      wta[(d4 + 0) * 72 + cch] = f2bf(va.x); wta[(d4 + 1) * 72 + cch] = f2bf(va.y);
      wta[(d4 + 2) * 72 + cch] = f2bf(va.z); wta[(d4 + 3) * 72 + cch] = f2bf(va.w);
      wtx[(d4 + 0) * 72 + cch] = f2bf(vx.x); wtx[(d4 + 1) * 72 + cch] = f2bf(vx.y);
      wtx[(d4 + 2) * 72 + cch] = f2bf(vx.z); wtx[(d4 + 3) * 72 + cch] = f2bf(vx.w);
    }
  }
  __syncthreads();
  {
    const int ch = tid & 63, gch = nb * 64 + ch;
    const float* cw = p->conv_w + (long)l * 4 * 512 + gch;
    const float w0 = cw[0], w1 = cw[512], w2 = cw[1024], w3 = cw[1536], cb = p->conv_b[l * 512 + gch];
#pragma unroll
    for (int i = 0; i < 16; ++i) {
      const int tok = (tid >> 6) + 8 * i;
      const float v = cb + w0 * bf2f(cxs[(tok + 0) * 64 + ch]) + w1 * bf2f(cxs[(tok + 1) * 64 + ch]) +
                      w2 * bf2f(cxs[(tok + 2) * 64 + ch]) + w3 * bf2f(cxs[(tok + 3) * 64 + ch]);
      xcs[tok * 72 + ch] = f2bf(v);
    }
  }
  __syncthreads();
  {
    bf16x8 a[2];
#pragma unroll
    for (int ks = 0; ks < 2; ++ks) a[ks] = *(const bf16x8*)(xcs + (wid * 16 + fr) * 72 + ks * 32 + fq * 8);
#pragma unroll
    for (int nk = 0; nk < 4; ++nk) {
      f32x4 ra = f32x4{0.f, 0.f, 0.f, 0.f}, ia = f32x4{0.f, 0.f, 0.f, 0.f};
#pragma unroll
      for (int ks = 0; ks < 2; ++ks) {
        bf16x8 ba = *(const bf16x8*)(wta + (nk * 16 + fr) * 72 + ks * 32 + fq * 8);
        bf16x8 bx = *(const bf16x8*)(wtx + (nk * 16 + fr) * 72 + ks * 32 + fq * 8);
        ra = __builtin_amdgcn_mfma_f32_16x16x32_bf16(a[ks], ba, ra, 0, 0, 0);
        ia = __builtin_amdgcn_mfma_f32_16x16x32_bf16(a[ks], bx, ia, 0, 0, 0);
      }
      const int ch = nk * 16 + fr, gch = nb * 64 + ch;
      const float ba_ = p->lru_b_a[l * 512 + gch], bx_ = p->lru_b_x[l * 512 + gch];
      const float sp = log1pf(__expf(-p->lru_lambda[l * 512 + gch]));
      const float* cw = p->conv_w + (long)l * 4 * 512 + gch;
      const float w0 = cw[0], w1 = cw[512], w2 = cw[1024], w3 = cw[1536], cb = p->conv_b[l * 512 + gch];
#pragma unroll
      for (int reg = 0; reg < 4; ++reg) {
        const int tok = wid * 16 + 4 * fq + reg;
        const float r = sigmoidf_(ra[reg] + ba_), ig = sigmoidf_(ia[reg] + bx_);
        const float log_a = -8.0f * r * sp;
        const float av = __expf(log_a);
        const float mult = sqrtf(fmaxf(1.0f - __expf(2.0f * log_a), 0.f));
        const float xc = cb + w0 * bf2f(cxs[(tok + 0) * 64 + ch]) + w1 * bf2f(cxs[(tok + 1) * 64 + ch]) +
                         w2 * bf2f(cxs[(tok + 2) * 64 + ch]) + w3 * bf2f(cxs[(tok + 3) * 64 + ch]);
        as_[tok * 64 + ch] = av;
        bs_[tok * 64 + ch] = mult * ig * xc;
      }
    }
  }
  __syncthreads();
  {
    const int ch = tid & 63, seg = tid >> 6;
    float P = 1.f, hh = 0.f;
#pragma unroll
    for (int i = 0; i < 16; ++i) {
      const int idx = (seg * 16 + i) * 64 + ch;
      const float a = as_[idx], b = bs_[idx];
      hh = a * hh + b; P *= a;
      as_[idx] = P; bs_[idx] = hh;
    }
    segA[seg * 64 + ch] = P; segH[seg * 64 + ch] = hh;
  }
  __syncthreads();
  if (tid < 64) {
    const int ch = tid;
    float carry = 0.f;
    if (APPLY) {
      const float* pa = p->lruA + (long)(bb * 64) * 512 + nb * 64 + ch;
      const float* ph = p->lruH + (long)(bb * 64) * 512 + nb * 64 + ch;
#pragma unroll 4
      for (int cc = 0; cc < ck; ++cc) carry = pa[cc * 512] * carry + ph[cc * 512];
    }
    float At = 1.f;
#pragma unroll
    for (int sg = 0; sg < 8; ++sg) {
      cin[sg * 64 + ch] = carry;
      const float a = segA[sg * 64 + ch];
      carry = a * carry + segH[sg * 64 + ch]; At *= a;
    }
    if (!APPLY) {
      p->lruA[(long)(bb * 64 + ck) * 512 + nb * 64 + ch] = At;
      p->lruH[(long)(bb * 64 + ck) * 512 + nb * 64 + ch] = carry;
    }
  }
  if (APPLY) {
    __syncthreads();
    const int ch = tid & 63, seg = tid >> 6;
    const float c0 = cin[seg * 64 + ch];
#pragma unroll
    for (int i = 0; i < 16; ++i) {
      const int tok = seg * 16 + i, idx = tok * 64 + ch;
      const float hv = bs_[idx] + as_[idx] * c0;
      bf16_t* gp = p->proj + (row0 + tok) * INW + C_CG + nb * 64 + ch;
      *gp = f2bf(hv * siluf_(bf2f(*gp)));
    }
  }
}

__device__ void phase_mix1(PP p, int c, int l) {
  constexpr int N_SWA = CB * 64 * 8, N_MEM = CB * 64 * 4, N_LRU = CB * 64 * 8;
  for (int i = blockIdx.x; i < N_SWA + N_MEM + N_LRU; i += gridDim.x) {
    if (i < N_SWA) { const int h = i & 7, qb = (i >> 3) & 63, bb = i >> 9; attn_item<64, 0>(p, c, l, bb, qb, h); }
    else if (i < N_SWA + N_MEM) { const int j = i - N_SWA, h = j & 3, qb = (j >> 2) & 63, bb = j >> 8; attn_item<128, 2>(p, c, l, bb, qb, h); }
    else { const int j = i - N_SWA - N_MEM, nb = j & 7, ck = (j >> 3) & 63, bb = j >> 9; lru_item<0>(p, l, bb, ck, nb); }
  }
}
__device__ void phase_mix2(PP p, int c, int l) {
  constexpr int N_SB = CB * 64 * 8, N_LRU = CB * 64 * 8;
  for (int i = blockIdx.x; i < N_SB + N_LRU; i += gridDim.x) {
    if (i < N_SB) { const int h = i & 7, qb = (i >> 3) & 63, bb = i >> 9; attn_item<64, 1>(p, c, l, bb, qb, h); }
    else { const int j = i - N_SB, nb = j & 7, ck = (j >> 3) & 63, bb = j >> 9; lru_item<1>(p, l, bb, ck, nb); }
  }
}

constexpr int NPHASE = 1 + NCHUNK * 2 * 5;
__global__ void __launch_bounds__(512) mega(Params p_arg, int ph_lo, int ph_hi) {
  cg::grid_group grid = cg::this_grid();
#pragma unroll 1
  for (int ph = ph_lo; ph < ph_hi; ++ph) {
    if (ph > ph_lo) grid.sync();
    PP p = (PP)__builtin_amdgcn_kernarg_segment_ptr();
    asm volatile("" : "+s"(p));
    if (ph == 0) { if (PM & 1) phase_prep(p); continue; }
    const int q = ph - 1, kind = q % 5, cl = q / 5, c = cl >> 1, l = cl & 1;
    if (kind == 0) { if (PM & 2) phase_g1(p, c, l); }
    else if (kind == 1) { if (PM & 4) phase_mix1(p, c, l); }
    else if (kind == 2) { if (PM & 8) phase_mix2(p, c, l); }
    else if (kind == 3) { if (PM & 16) phase_g2(p, c, l); }
    else { if (PM & 32) phase_g3(p, c, l); }
  }
}

extern "C" void kernel_launch(void* const* d_in, const int* in_sizes, int n_in, void* d_out, int out_size, void* d_ws,
                              size_t ws_size, hipStream_t stream) {
  static int grid_blocks = 0;
  if (!grid_blocks) {
    int dev = 0, cus = 0, per_cu = 0;
    hipGetDevice(&dev);
    hipDeviceGetAttribute(&cus, hipDeviceAttributeMultiprocessorCount, dev);
    hipFuncSetAttribute((const void*)mega, hipFuncAttributeMaxDynamicSharedMemorySize, LDS_BYTES);
    hipOccupancyMaxActiveBlocksPerMultiprocessor(&per_cu, (const void*)mega, 512, LDS_BYTES);
    if (per_cu < 1) per_cu = 1;
    grid_blocks = cus * 1;
    (void)hipGetLastError();
  }
  Params p{};
  const float* const* in = (const float* const*)d_in;
  p.x = in[0]; p.mem = in[1]; p.norm_gain = in[2]; p.w_in = in[3]; p.swa_q_gain = in[4]; p.swa_k_gain = in[5];
  p.swa_sinks = in[6]; p.conv_w = in[7]; p.conv_b = in[8]; p.lru_w_a = in[9]; p.lru_b_a = in[10]; p.lru_w_x = in[11];
  p.lru_b_x = in[12]; p.lru_lambda = in[13]; p.mem_norm_gain = in[14]; p.w_mem_kv = in[15]; p.mem_q_gain = in[16];
  p.mem_k_gain = in[17]; p.w_branch = in[18]; p.w_out = in[19];
  p.out = (float*)d_out;
  char* ws = (char*)d_ws; size_t off = 0;
  auto take = [&](size_t bytes) { char* r = ws + off; off += (bytes + 255) & ~(size_t)255; return r; };
  p.WinT = (bf16_t*)take((size_t)2 * INW * DM * 2);
  p.WbrT = (bf16_t*)take((size_t)8 * DM * 512 * 2);
  p.WoutT = (bf16_t*)take((size_t)2 * DM * DM * 2);
  p.WmkvT = (bf16_t*)take((size_t)2 * DM * DM * 2);
  p.xb = (bf16_t*)take((size_t)NTOK * DM * 2);
  p.memb = (bf16_t*)take((size_t)BATCH * 256 * DM * 2);
  p.mkv = (bf16_t*)take((size_t)2 * BATCH * 256 * DM * 2);
  p.ssq_x = (float*)take((size_t)2 * NTOK * 4);
  p.ssq_mem = (float*)take((size_t)BATCH * 256 * 4);
  p.lruA = (float*)take((size_t)CB * 64 * 512 * 4);
  p.lruH = (float*)take((size_t)CB * 64 * 512 * 4);
  p.proj = (bf16_t*)take((size_t)CT * INW * 2);
  if (off > ws_size) { fprintf(stderr, "kernel_launch: workspace too small: need %zu have %zu\n", off, ws_size); return; }
#if COOP
  int lo = 0, hi = NPHASE;
  void* args[] = {&p, &lo, &hi};
  hipError_t e = hipLaunchCooperativeKernel((const void*)mega, dim3(grid_blocks), dim3(512), args, LDS_BYTES, stream);
  if (e != hipSuccess) fprintf(stderr, "cooperative launch failed: %s (grid %d)\n", hipGetErrorString(e), grid_blocks);
#else
  for (int ph = 0; ph < NPHASE; ++ph) mega<<<grid_blocks, 512, LDS_BYTES, stream>>>(p, ph, ph + 1);
#endif
}
```

```cpp
#include <hip/hip_runtime.h>
#include <hip/hip_cooperative_groups.h>
#include <cstdint>
#include <cstdio>
namespace cg = cooperative_groups;

#ifndef PM
#define PM 63
#endif
#ifndef PROBE
#define PROBE 0
#endif
#ifndef COOP
#define COOP 1
#endif

typedef unsigned short bf16_t;
typedef short bf16x8 __attribute__((ext_vector_type(8)));
typedef float f32x4 __attribute__((ext_vector_type(4)));

constexpr int DM = 1024, BATCH = 4, SEQ = 8192, NTOK = BATCH * SEQ, INW = 9472;
constexpr int CB = 2, CT = CB * SEQ, NCHUNK = BATCH / CB;
constexpr int C_AQ = 0, C_AK = 512, C_AV = 640, C_AG = 768, C_BQ = 1280, C_BK = 1792, C_BV = 2304, C_BG = 2816,
              C_CX = 3328, C_CG = 3840, C_MQ = 4352, C_MG = 4864, C_MRG = 5376;
constexpr int LDS_BYTES = 131072;
constexpr float EPS = 1e-6f;
constexpr float LOG2E = 1.4426950408889634f;

struct Params {
  const float *x, *mem, *norm_gain, *w_in, *swa_q_gain, *swa_k_gain, *swa_sinks, *conv_w, *conv_b,
      *lru_w_a, *lru_b_a, *lru_w_x, *lru_b_x, *lru_lambda, *mem_norm_gain, *w_mem_kv,
      *mem_q_gain, *mem_k_gain, *w_branch, *w_out;
  float* out;
  bf16_t *WinT, *WbrT, *WoutT, *WmkvT, *xb, *memb, *mkv, *proj;
  float *ssq_x, *ssq_mem, *lruA, *lruH;
  unsigned* bar;
};

typedef const __attribute__((address_space(4))) Params* PP;
extern __shared__ __attribute__((aligned(16))) char smem[];
__device__ __forceinline__ int otid() { int t = threadIdx.x; asm volatile("" : "+v"(t)); return t; }

typedef __bf16 bf16v2 __attribute__((ext_vector_type(2)));
typedef float f32v2 __attribute__((ext_vector_type(2)));
__device__ __forceinline__ unsigned cvt_pk_bf16(float lo, float hi) {
  f32v2 v = {lo, hi};
  return __builtin_bit_cast(unsigned, __builtin_convertvector(v, bf16v2));
}
__device__ __forceinline__ bf16_t f2bf(float f) { return (bf16_t)(cvt_pk_bf16(f, 0.f) & 0xffffu); }
__device__ __forceinline__ float bf2f(bf16_t b) { return __uint_as_float(((unsigned)b) << 16); }
__device__ __forceinline__ float bflo(unsigned w) { return __uint_as_float(w << 16); }
__device__ __forceinline__ float bfhi(unsigned w) { return __uint_as_float(w & 0xffff0000u); }
__device__ __forceinline__ float fexp2(float x) { return __builtin_amdgcn_exp2f(x); }
__device__ __forceinline__ float flog2(float x) { return __builtin_amdgcn_logf(x); }
__device__ __forceinline__ float frcp(float x) { return __builtin_amdgcn_rcpf(x); }
__device__ __forceinline__ float sigmoidf_(float x) { return frcp(1.0f + fexp2(-x * LOG2E)); }
__device__ __forceinline__ float siluf_(float x) { return x * sigmoidf_(x); }

__device__ __forceinline__ int lds_byte(int r, int c) {
  int st = (r >> 4) * 2 + (c >> 5), rr = r & 15, cc = c & 31, ob = rr * 64 + cc * 2;
  return st * 1024 + (ob ^ (((ob >> 9) & 1) << 5));
}
__device__ __forceinline__ void stage_rc(int b, int& R, int& C) {
  int st = b / 1024, sb = b % 1024, swz = sb ^ (((sb >> 9) & 1) << 5);
  R = (st >> 1) * 16 + swz / 64; C = (st & 1) * 32 + (swz % 64) / 2;
}

#define WAIT_VN(N) asm volatile("s_waitcnt vmcnt(%0)" ::"n"(N) : "memory")
#define WAIT_L(n) asm volatile("s_waitcnt lgkmcnt(" #n ")" ::: "memory")
#define BAR __builtin_amdgcn_s_barrier()
#define SCHED __builtin_amdgcn_sched_barrier(0)

template <int AM>
__device__ __forceinline__ void gemm_kloop(const bf16_t* __restrict__ A, const int lda, const bf16_t* __restrict__ Bt,
                                           const int ldb, const int K, f32x4 (&acc)[2][2][AM][2]) {
  constexpr int LA = AM / 2, HA = 32 * AM;
  constexpr int W1 = 2 + LA, W2 = 4 + LA, W3 = LA;
  const int tid = otid(), wid = tid >> 6, lane = tid & 63, wr = wid >> 2, wc = wid & 3, fr = lane & 15, fq = lane >> 4;
  int aoff[LA], boff[2];
#pragma unroll
  for (int i = 0; i < LA; ++i) { int r, c; stage_rc(tid * 16 + i * 8192, r, c); aoff[i] = r * lda + c; }
#pragma unroll
  for (int i = 0; i < 2; ++i) { int r, c; stage_rc(tid * 16 + i * 8192, r, c); boff[i] = r * ldb + c; }
  const bf16_t* A0 = A; const bf16_t* A1 = A + (long)HA * lda;
  const bf16_t* B0p = Bt; const bf16_t* B1p = Bt + (long)128 * ldb;
#define SA_(b, h) (smem + ((b) * 2 + (h)) * 16384)
#define SB_(b, h) (smem + (4 + (b) * 2 + (h)) * 16384)
#define STG_A(b, h, kt) do { _Pragma("unroll") for (int _i = 0; _i < LA; ++_i) \
    __builtin_amdgcn_global_load_lds((const unsigned*)(((h) ? A1 : A0) + (kt) * 64 + aoff[_i]), (unsigned*)(SA_(b, h) + tid * 16 + _i * 8192), 16, 0, 0); } while (0)
#define STG_B(b, h, kt) do { _Pragma("unroll") for (int _i = 0; _i < 2; ++_i) \
    __builtin_amdgcn_global_load_lds((const unsigned*)(((h) ? B1p : B0p) + (kt) * 64 + boff[_i]), (unsigned*)(SB_(b, h) + tid * 16 + _i * 8192), 16, 0, 0); } while (0)
#define LDA_(dst, b, h) _Pragma("unroll") for (int m = 0; m < AM; ++m) _Pragma("unroll") for (int k = 0; k < 2; ++k) \
    dst[m][k] = *reinterpret_cast<const bf16x8*>(SA_(b, h) + lds_byte(wr * (16 * AM) + m * 16 + fr, k * 32 + fq * 8))
#define LDB_(dst, b, h) _Pragma("unroll") for (int n = 0; n < 2; ++n) _Pragma("unroll") for (int k = 0; k < 2; ++k) \
    dst[n][k] = *reinterpret_cast<const bf16x8*>(SB_(b, h) + lds_byte(wc * 32 + n * 16 + fr, k * 32 + fq * 8))
#define MMA_(ai, bj, At, Bx) do { __builtin_amdgcn_s_setprio(1); \
    _Pragma("unroll") for (int m = 0; m < AM; ++m) _Pragma("unroll") for (int n = 0; n < 2; ++n) _Pragma("unroll") for (int k = 0; k < 2; ++k) \
      acc[ai][bj][m][n] = __builtin_amdgcn_mfma_f32_16x16x32_bf16(Bx[n][k], At[m][k], acc[ai][bj][m][n], 0, 0, 0); \
    __builtin_amdgcn_s_setprio(0); } while (0)

  bf16x8 At[AM][2], Bf0[2][2], Bf1[2][2];
  const int nt = K / 64;
  STG_B(0, 0, 0); STG_A(0, 0, 0); STG_B(0, 1, 0); STG_A(0, 1, 0);
  if (wr == 1) BAR;
  WAIT_VN(W1); BAR;
  STG_B(1, 0, 1); STG_A(1, 0, 1); STG_B(1, 1, 1);
  WAIT_VN(W2); BAR;
  for (int t = 0; t < nt - 2; t += 2) {
    LDB_(Bf0, 0, 0); SCHED; LDA_(At, 0, 0); STG_A(1, 1, t + 1);
    WAIT_L(8); BAR; WAIT_L(0); MMA_(0, 0, At, Bf0); BAR; SCHED;
    LDB_(Bf1, 0, 1); STG_B(0, 0, t + 2);
    BAR; WAIT_L(0); MMA_(0, 1, At, Bf1); BAR;
    LDA_(At, 0, 1); STG_A(0, 0, t + 2);
    BAR; WAIT_L(0); MMA_(1, 0, At, Bf0); BAR; SCHED;
    STG_B(0, 1, t + 2);
    WAIT_VN(W2); BAR; MMA_(1, 1, At, Bf1); BAR;
    LDB_(Bf0, 1, 0); SCHED; LDA_(At, 1, 0); STG_A(0, 1, t + 2);
    WAIT_L(8); BAR; WAIT_L(0); MMA_(0, 0, At, Bf0); BAR; SCHED;
    LDB_(Bf1, 1, 1); STG_B(1, 0, t + 3);
    BAR; WAIT_L(0); MMA_(0, 1, At, Bf1); BAR;
    LDA_(At, 1, 1); STG_A(1, 0, t + 3);
    BAR; WAIT_L(0); MMA_(1, 0, At, Bf0); BAR; SCHED;
    STG_B(1, 1, t + 3);
    WAIT_VN(W2); BAR; MMA_(1, 1, At, Bf1); BAR;
  }
  { LDB_(Bf0, 0, 0); LDA_(At, 0, 0); STG_A(1, 1, nt - 1);
    BAR; WAIT_L(0); MMA_(0, 0, At, Bf0); BAR;
    LDB_(Bf1, 0, 1); BAR; WAIT_L(0); MMA_(0, 1, At, Bf1); BAR;
    LDA_(At, 0, 1); WAIT_VN(W1); BAR; WAIT_L(0); MMA_(1, 0, At, Bf0); MMA_(1, 1, At, Bf1); BAR; }
  { LDB_(Bf0, 1, 0); LDA_(At, 1, 0); WAIT_VN(W3); BAR; WAIT_L(0); MMA_(0, 0, At, Bf0); BAR;
    LDB_(Bf1, 1, 1); WAIT_VN(0); BAR; WAIT_L(0); MMA_(0, 1, At, Bf1); BAR;
    LDA_(At, 1, 1); BAR; WAIT_L(0); MMA_(1, 0, At, Bf0); MMA_(1, 1, At, Bf1); BAR; }
  if (wr == 0) BAR;
}

__device__ __forceinline__ void tile_remap(int L, int nM, int nN, int& pm, int& pn) {
  const int nwg = nM * nN; int wgid = L;
  const int q = nwg / 8, r = nwg % 8, xcd = wgid % 8, off = wgid / 8;
  wgid = (xcd < r ? xcd * (q + 1) : r * (q + 1) + (xcd - r) * q) + off;
  const int nig = 8 * nN, gid = wgid / nig, fm = gid * 8, gsz = min(nM - fm, 8);
  pm = fm + ((wgid % nig) % gsz); pn = (wgid % nig) / gsz;
}

__device__ __forceinline__ void transpose_tile(const float* __restrict__ src, int N, bf16_t* __restrict__ dst, int K,
                                               int k0, int n0, const float* __restrict__ scale) {
  float* tile = (float*)smem;
  const int tid = otid();
  __syncthreads();
#pragma unroll
  for (int e = tid; e < 4096; e += 512) {
    int kk = e >> 6, nn = e & 63;
    float v = src[(long)(k0 + kk) * N + n0 + nn];
    if (scale) v *= scale[k0 + kk];
    tile[kk * 65 + nn] = v;
  }
  __syncthreads();
#pragma unroll
  for (int e = tid; e < 4096; e += 512) {
    int nn = e >> 6, kk = e & 63;
    dst[(long)(n0 + nn) * K + k0 + kk] = f2bf(tile[kk * 65 + nn]);
  }
}

__device__ void phase_prep(PP p) {
  const int tid = otid(), wid = tid >> 6, lane = tid & 63;
  constexpr int U_IN = 16 * 148, U_BR = 8 * 16, U_SQ = 16 * 16;
  constexpr int NU = 2 * U_IN + 8 * U_BR + 2 * U_SQ + 2 * U_SQ;
  for (int u = blockIdx.x; u < NU; u += gridDim.x) {
    if (u < 2 * U_IN) {
      int l = u / U_IN, v = u % U_IN, kt = v / 148, nt = v % 148;
      transpose_tile(p->w_in + (long)l * DM * INW, INW, p->WinT + (long)l * INW * DM, DM, kt * 64, nt * 64, p->norm_gain + l * DM);
    } else if (u < 2 * U_IN + 8 * U_BR) {
      int v = u - 2 * U_IN, ln = v / U_BR, w = v % U_BR, kt = w / 16, nt = w % 16;
      transpose_tile(p->w_branch + (long)ln * 512 * DM, DM, p->WbrT + (long)ln * DM * 512, 512, kt * 64, nt * 64, nullptr);
    } else if (u < 2 * U_IN + 8 * U_BR + 2 * U_SQ) {
      int v = u - (2 * U_IN + 8 * U_BR), l = v / U_SQ, w = v % U_SQ, kt = w / 16, nt = w % 16;
      transpose_tile(p->w_out + (long)l * DM * DM, DM, p->WoutT + (long)l * DM * DM, DM, kt * 64, nt * 64, nullptr);
    } else {
      int v = u - (2 * U_IN + 8 * U_BR + 2 * U_SQ), l = v / U_SQ, w = v % U_SQ, kt = w / 16, nt = w % 16;
      transpose_tile(p->w_mem_kv + (long)l * DM * DM, DM, p->WmkvT + (long)l * DM * DM, DM, kt * 64, nt * 64, p->mem_norm_gain + l * DM);
    }
  }
  for (int r = blockIdx.x * 8 + wid; r < NTOK + BATCH * 256; r += gridDim.x * 8) {
    const float* src; bf16_t* dst; float* sq;
    if (r < NTOK) { src = p->x + (long)r * DM; dst = p->xb + (long)r * DM; sq = p->ssq_x + r; }
    else { int m = r - NTOK; src = p->mem + (long)m * DM; dst = p->memb + (long)m * DM; sq = p->ssq_mem + m; }
    float ss = 0.f;
#pragma unroll
    for (int i = 0; i < 4; ++i) {
      float4 v = *(const float4*)(src + (i * 64 + lane) * 4);
      ss += v.x * v.x + v.y * v.y + v.z * v.z + v.w * v.w;
      uint2 pk; pk.x = cvt_pk_bf16(v.x, v.y); pk.y = cvt_pk_bf16(v.z, v.w);
      *(uint2*)(dst + (i * 64 + lane) * 4) = pk;
    }
#pragma unroll
    for (int o = 32; o >= 1; o >>= 1) ss += __shfl_xor(ss, o);
    if (lane == 0) *sq = ss;
  }
  for (int i = blockIdx.x * 512 + tid; i < NTOK; i += gridDim.x * 512) p->ssq_x[NTOK + i] = 0.f;
}

__device__ void phase_g1(PP p, int c, int l) {
  const int tid = otid(), wid = tid >> 6, lane = tid & 63, wr = wid >> 2, wc = wid & 3, fr = lane & 15, fq = lane >> 4;
  constexpr int nM = CT / 256, nN = INW / 256, NT1 = nM * nN;
  const int ntiles = NT1 + ((c == 0 && l == 0) ? 32 : 0);
  for (int i = blockIdx.x; i < ntiles; i += gridDim.x) {
    const bf16_t *A, *Bt; const float* ssq; bf16_t* out; int ldo;
    if (i < NT1) {
      int pm, pn; tile_remap(i, nM, nN, pm, pn);
      A = p->xb + ((long)c * CT + pm * 256) * DM; Bt = p->WinT + ((long)l * INW + pn * 256) * DM;
      ssq = p->ssq_x + (long)l * NTOK + c * CT + pm * 256; out = p->proj + (long)pm * 256 * INW + pn * 256; ldo = INW;
    } else {
      int j = i - NT1, ll = j >> 4, pm = (j & 15) >> 2, pn = j & 3;
      A = p->memb + (long)pm * 256 * DM; Bt = p->WmkvT + ((long)ll * DM + pn * 256) * DM;
      ssq = p->ssq_mem + pm * 256; out = p->mkv + ((long)ll * 1024 + pm * 256) * DM + pn * 256; ldo = DM;
    }
    f32x4 acc[2][2][4][2];
#pragma unroll
    for (int a = 0; a < 2; ++a)
#pragma unroll
      for (int b = 0; b < 2; ++b)
#pragma unroll
        for (int m = 0; m < 4; ++m)
#pragma unroll
          for (int n = 0; n < 2; ++n) acc[a][b][m][n] = f32x4{0.f, 0.f, 0.f, 0.f};
    gemm_kloop<4>(A, DM, Bt, DM, DM, acc);
#pragma unroll
    for (int ai = 0; ai < 2; ++ai)
#pragma unroll
      for (int m = 0; m < 4; ++m) {
        const int r = ai * 128 + wr * 64 + m * 16 + fr;
        const float rs = rsqrtf(ssq[r] * (1.0f / DM) + EPS);
        bf16_t* o = out + (long)r * ldo + wc * 32 + fq * 4;
#pragma unroll
        for (int bj = 0; bj < 2; ++bj)
#pragma unroll
          for (int n = 0; n < 2; ++n) {
            f32x4 v = acc[ai][bj][m][n];
            uint2 pk; pk.x = cvt_pk_bf16(v[0] * rs, v[1] * rs); pk.y = cvt_pk_bf16(v[2] * rs, v[3] * rs);
            *(uint2*)(o + bj * 128 + n * 16) = pk;
          }
      }
  }
}

__device__ void phase_g2(PP p, int c, int l) {
  const int tid = otid(), wid = tid >> 6, lane = tid & 63, wr = wid >> 2, wc = wid & 3, fr = lane & 15, fq = lane >> 4;
  constexpr int NT = (CT / 128) * 4;
  for (int i = blockIdx.x; i < NT; i += gridDim.x) {
    const int pm = i >> 2, pn = i & 3;
    f32x4 mix[2][2][2][2];
#pragma unroll
    for (int a = 0; a < 2; ++a)
#pragma unroll
      for (int b = 0; b < 2; ++b)
#pragma unroll
        for (int m = 0; m < 2; ++m)
#pragma unroll
          for (int n = 0; n < 2; ++n) mix[a][b][m][n] = f32x4{0.f, 0.f, 0.f, 0.f};
    bf16_t* prow = p->proj + (long)pm * 128 * INW;
#pragma unroll 1
    for (int n4 = 0; n4 < 4; ++n4) {
      const int bcol = (n4 == 0) ? C_AQ : (n4 == 1) ? C_BQ : (n4 == 2) ? C_CG : C_MQ;
      f32x4 acc[2][2][2][2];
#pragma unroll
      for (int a = 0; a < 2; ++a)
#pragma unroll
        for (int b = 0; b < 2; ++b)
#pragma unroll
          for (int m = 0; m < 2; ++m)
#pragma unroll
            for (int n = 0; n < 2; ++n) acc[a][b][m][n] = f32x4{0.f, 0.f, 0.f, 0.f};
      gemm_kloop<2>(prow + bcol, INW, p->WbrT + ((long)(l * 4 + n4) * DM + pn * 256) * 512, 512, 512, acc);
#pragma unroll
      for (int ai = 0; ai < 2; ++ai)
#pragma unroll
        for (int m = 0; m < 2; ++m) {
          const int r = ai * 64 + wr * 32 + m * 16 + fr;
          const bf16_t* g = prow + (long)r * INW + C_MRG + n4 * DM + pn * 256 + wc * 32 + fq * 4;
#pragma unroll
          for (int bj = 0; bj < 2; ++bj)
#pragma unroll
            for (int n = 0; n < 2; ++n) {
              uint2 gv = *(const uint2*)(g + bj * 128 + n * 16);
              f32x4 v = acc[ai][bj][m][n];
              mix[ai][bj][m][n][0] += sigmoidf_(bflo(gv.x)) * v[0];
              mix[ai][bj][m][n][1] += sigmoidf_(bfhi(gv.x)) * v[1];
              mix[ai][bj][m][n][2] += sigmoidf_(bflo(gv.y)) * v[2];
              mix[ai][bj][m][n][3] += sigmoidf_(bfhi(gv.y)) * v[3];
            }
        }
    }
#pragma unroll
    for (int ai = 0; ai < 2; ++ai)
#pragma unroll
      for (int m = 0; m < 2; ++m) {
        const int r = ai * 64 + wr * 32 + m * 16 + fr;
        bf16_t* o = prow + (long)r * INW + C_MRG + pn * 256 + wc * 32 + fq * 4;
#pragma unroll
        for (int bj = 0; bj < 2; ++bj)
#pragma unroll
          for (int n = 0; n < 2; ++n) {
            f32x4 v = mix[ai][bj][m][n];
            uint2 pk; pk.x = cvt_pk_bf16(v[0], v[1]); pk.y = cvt_pk_bf16(v[2], v[3]);
            *(uint2*)(o + bj * 128 + n * 16) = pk;
          }
      }
  }
}

__device__ void phase_g3(PP p, int c, int l) {
  const int tid = otid(), wid = tid >> 6, lane = tid & 63, wr = wid >> 2, wc = wid & 3, fr = lane & 15, fq = lane >> 4;
  constexpr int NT = (CT / 256) * 4;
  for (int i = blockIdx.x; i < NT; i += gridDim.x) {
    const int pm = i >> 2, pn = i & 3;
    f32x4 acc[2][2][4][2];
#pragma unroll
    for (int a = 0; a < 2; ++a)
#pragma unroll
      for (int b = 0; b < 2; ++b)
#pragma unroll
        for (int m = 0; m < 4; ++m)
#pragma unroll
          for (int n = 0; n < 2; ++n) acc[a][b][m][n] = f32x4{0.f, 0.f, 0.f, 0.f};
    gemm_kloop<4>(p->proj + (long)pm * 256 * INW + C_MRG, INW, p->WoutT + ((long)l * DM + pn * 256) * DM, DM, DM, acc);
    const float* xold = (l == 0) ? p->x : p->out;
#pragma unroll
    for (int ai = 0; ai < 2; ++ai)
#pragma unroll
      for (int m = 0; m < 4; ++m) {
        const long gr = (long)c * CT + pm * 256 + ai * 128 + wr * 64 + m * 16 + fr;
        const long base = gr * DM + pn * 256 + wc * 32 + fq * 4;
        float ss = 0.f;
#pragma unroll
        for (int bj = 0; bj < 2; ++bj)
#pragma unroll
          for (int n = 0; n < 2; ++n) {
            const long off = base + bj * 128 + n * 16;
            float4 xo = *(const float4*)(xold + off);
            f32x4 v = acc[ai][bj][m][n];
            float4 xn; xn.x = xo.x + v[0]; xn.y = xo.y + v[1]; xn.z = xo.z + v[2]; xn.w = xo.w + v[3];
            *(float4*)(p->out + off) = xn;
            if (l == 0) {
              uint2 pk; pk.x = cvt_pk_bf16(xn.x, xn.y); pk.y = cvt_pk_bf16(xn.z, xn.w);
              *(uint2*)(p->xb + off) = pk;
              ss += xn.x * xn.x + xn.y * xn.y + xn.z * xn.z + xn.w * xn.w;
            }
          }
        if (l == 0) {
          ss += __shfl_xor(ss, 16); ss += __shfl_xor(ss, 32);
          if (fq == 0) atomicAdd(p->ssq_x + NTOK + gr, ss);
        }
      }
  }
}

template <int D, int MODE>
__device__ void attn_item(PP p, int c, int l, int bb, int qb, int h) {
  constexpr int KP = D + 8, VP = 132, NKS = D / 32, NDS = D / 16;
  constexpr int TPR = D / 8, RPP = 512 / TPR, NP = 128 / RPP;
  bf16_t* Ks = (bf16_t*)smem;
  bf16_t* Vt = (bf16_t*)(smem + 128 * KP * 2);
  int* flags = (int*)(smem + 128 * KP * 2 + D * VP * 2);
  const int tid = otid(), wid = tid >> 6, lane = tid & 63, fr = lane & 15, fq = lane >> 4;
  const float sc = LOG2E * (D == 64 ? 0.125f : 0.08838834764831845f);
  const int qcol = (MODE == 0 ? C_AQ : MODE == 1 ? C_BQ : C_MQ) + h * D;
  const int gcol = (MODE == 0 ? C_AG : MODE == 1 ? C_BG : C_MG) + h * D;
  const long rowQ = (long)bb * SEQ + qb * 128 + wid * 16 + fr;
  bf16_t* qptr = p->proj + rowQ * INW + qcol;
  const int qi = wid * 16 + fr;

  bf16x8 qf[NKS];
  {
    float qv[NKS][8]; float ss = 0.f;
#pragma unroll
    for (int ks = 0; ks < NKS; ++ks) {
      uint4 u = *(const uint4*)(qptr + ks * 32 + fq * 8);
      qv[ks][0] = bflo(u.x); qv[ks][1] = bfhi(u.x); qv[ks][2] = bflo(u.y); qv[ks][3] = bfhi(u.y);
      qv[ks][4] = bflo(u.z); qv[ks][5] = bfhi(u.z); qv[ks][6] = bflo(u.w); qv[ks][7] = bfhi(u.w);
#pragma unroll
      for (int i = 0; i < 8; ++i) ss += qv[ks][i] * qv[ks][i];
    }
    float rs = sc;
    const float* qg = (MODE == 0) ? (p->swa_q_gain + l * 64) : (p->mem_q_gain + l * 128);
    if (MODE != 1) {
      ss += __shfl_xor(ss, 16); ss += __shfl_xor(ss, 32);
      rs = rsqrtf(ss * (1.0f / D) + EPS) * sc;
    }
#pragma unroll
    for (int ks = 0; ks < NKS; ++ks) {
      float g[8];
#pragma unroll
      for (int i = 0; i < 8; ++i) g[i] = (MODE != 1) ? qg[ks * 32 + fq * 8 + i] * rs : rs;
      union { unsigned u[4]; bf16x8 v; } cv;
#pragma unroll
      for (int i = 0; i < 4; ++i) cv.u[i] = cvt_pk_bf16(qv[ks][2 * i] * g[2 * i], qv[ks][2 * i + 1] * g[2 * i + 1]);
      qf[ks] = cv.v;
    }
  }

  bf16x8 uop[2];
  if (MODE == 1) {
#pragma unroll
    for (int ss_ = 0; ss_ < 2; ++ss_) {
      const int srow = ss_ * 16 + fr;
#pragma unroll
      for (int i = 0; i < 8; ++i) {
        const int j = (i < 4) ? (4 * fq + i) : (16 + 4 * fq + (i - 4));
        uop[ss_][i] = (j >= srow) ? (short)0x3F80 : (short)0;
      }
    }
  }

  f32x4 o[NDS];
#pragma unroll
  for (int d = 0; d < NDS; ++d) o[d] = f32x4{0.f, 0.f, 0.f, 0.f};
  float m_run = -1e30f, lsum = 0.f, R = 0.f;
  if (MODE == 0) m_run = p->swa_sinks[l * 8 + h] * LOG2E;

  const bf16_t *Kbase, *Vbase; int ldk; const float* kg = nullptr;
  if (MODE == 0) { Kbase = p->proj + (long)bb * SEQ * INW + C_AK + (h >> 2) * 64; Vbase = p->proj + (long)bb * SEQ * INW + C_AV + (h >> 2) * 64; ldk = INW; kg = p->swa_k_gain + l * 64; }
  else if (MODE == 1) { Kbase = p->proj + (long)bb * SEQ * INW + C_BK + h * 64; Vbase = p->proj + (long)bb * SEQ * INW + C_BV + h * 64; ldk = INW; }
  else { const int gb = c * CB + bb; Kbase = p->mkv + ((long)l * 1024 + gb * 256) * DM + h * 128; Vbase = Kbase + 512; ldk = DM; kg = p->mem_k_gain + l * 128; }

  const int ntile_max = (MODE == 0) ? 2 : (MODE == 2) ? 2 : (qb + 1);
#pragma unroll 1
  for (int tj = 0; tj < ntile_max; ++tj) {
    int krow0; bool diag = false, prev = false;
    if (MODE == 0) { if (tj == 0) { if (qb == 0) continue; krow0 = qb * 128 - 128; prev = true; } else { krow0 = qb * 128; diag = true; } }
    else if (MODE == 1) { krow0 = (qb - tj) * 128; diag = (tj == 0); }
    else { krow0 = tj * 128; }
    __syncthreads();
#pragma unroll
    for (int ps = 0; ps < NP; ++ps) {
      const int r = ps * RPP + tid / TPR, cc = tid % TPR;
      uint4 u = *(const uint4*)(Kbase + (long)(krow0 + r) * ldk + cc * 8);
      if (MODE != 1) {
        float f[8] = {bflo(u.x), bfhi(u.x), bflo(u.y), bfhi(u.y), bflo(u.z), bfhi(u.z), bflo(u.w), bfhi(u.w)};
        float ss = 0.f;
#pragma unroll
        for (int i = 0; i < 8; ++i) ss += f[i] * f[i];
#pragma unroll
        for (int off = 1; off < TPR; off <<= 1) ss += __shfl_xor(ss, off);
        const float rs = rsqrtf(ss * (1.0f / D) + EPS);
#pragma unroll
        for (int i = 0; i < 8; ++i) f[i] *= rs * kg[cc * 8 + i];
        u.x = cvt_pk_bf16(f[0], f[1]); u.y = cvt_pk_bf16(f[2], f[3]); u.z = cvt_pk_bf16(f[4], f[5]); u.w = cvt_pk_bf16(f[6], f[7]);
      }
      *(uint4*)(Ks + r * KP + cc * 8) = u;
      uint4 v = *(const uint4*)(Vbase + (long)(krow0 + r) * ldk + cc * 8);
      bf16_t* vd = Vt + (cc * 8) * VP + r;
      vd[0 * VP] = (bf16_t)(v.x & 0xffff); vd[1 * VP] = (bf16_t)(v.x >> 16);
      vd[2 * VP] = (bf16_t)(v.y & 0xffff); vd[3 * VP] = (bf16_t)(v.y >> 16);
      vd[4 * VP] = (bf16_t)(v.z & 0xffff); vd[5 * VP] = (bf16_t)(v.z >> 16);
      vd[6 * VP] = (bf16_t)(v.w & 0xffff); vd[7 * VP] = (bf16_t)(v.w >> 16);
    }
    __syncthreads();

#pragma unroll 1
    for (int gg = 0; gg < 4; ++gg) {
      const int g = (MODE == 1) ? (3 - gg) : gg;
      if (diag && g * 32 > wid * 16 + 15) continue;
      if (prev && g * 32 + 31 <= wid * 16) continue;
      f32x4 s[2];
#pragma unroll
      for (int sub = 0; sub < 2; ++sub) {
        s[sub] = f32x4{0.f, 0.f, 0.f, 0.f};
#pragma unroll
        for (int ks = 0; ks < NKS; ++ks) {
          bf16x8 a = *(const bf16x8*)(Ks + (g * 32 + sub * 16 + fr) * KP + ks * 32 + fq * 8);
          s[sub] = __builtin_amdgcn_mfma_f32_16x16x32_bf16(a, qf[ks], s[sub], 0, 0, 0);
        }
      }
      float w[8];
      if (MODE == 1) {
        float Lv[8], tot = 0.f; bool vld[8];
#pragma unroll
        for (int i = 0; i < 8; ++i) {
          const int kk = g * 32 + (i >> 2) * 16 + fq * 4 + (i & 3);
          vld[i] = !diag || (kk < qi);
          const float z2 = s[i >> 2][i & 3];
          const float lv = -(fmaxf(z2, 0.f) + flog2(1.0f + fexp2(-fabsf(z2))));
          Lv[i] = vld[i] ? lv : 0.f;
          tot += Lv[i];
        }
        tot += __shfl_xor(tot, 16); tot += __shfl_xor(tot, 32);
        union { unsigned u[4]; bf16x8 v; } hi, lo;
#pragma unroll
        for (int i = 0; i < 4; ++i) {
          const unsigned hp = cvt_pk_bf16(Lv[2 * i], Lv[2 * i + 1]);
          hi.u[i] = hp;
          lo.u[i] = cvt_pk_bf16(Lv[2 * i] - bflo(hp), Lv[2 * i + 1] - bfhi(hp));
        }
        f32x4 cs[2];
#pragma unroll
        for (int ss_ = 0; ss_ < 2; ++ss_) {
          cs[ss_] = f32x4{0.f, 0.f, 0.f, 0.f};
          cs[ss_] = __builtin_amdgcn_mfma_f32_16x16x32_bf16(uop[ss_], hi.v, cs[ss_], 0, 0, 0);
          cs[ss_] = __builtin_amdgcn_mfma_f32_16x16x32_bf16(uop[ss_], lo.v, cs[ss_], 0, 0, 0);
        }
#pragma unroll
        for (int i = 0; i < 8; ++i) {
          const float e = s[i >> 2][i & 3] + cs[i >> 2][i & 3] + R;
          w[i] = vld[i] ? fexp2(e) : 0.f;
        }
        R += tot;
      } else {
        float gmax = -1e30f;
#pragma unroll
        for (int i = 0; i < 8; ++i) {
          const int kk = g * 32 + (i >> 2) * 16 + fq * 4 + (i & 3);
          bool v = true;
          if (MODE == 0) v = diag ? (kk <= qi) : (kk > qi);
          w[i] = v ? s[i >> 2][i & 3] : -1e30f;
          gmax = fmaxf(gmax, w[i]);
        }
        gmax = fmaxf(gmax, __shfl_xor(gmax, 16)); gmax = fmaxf(gmax, __shfl_xor(gmax, 32));
        const float m_new = fmaxf(m_run, gmax);
        const float alpha = fexp2(m_run - m_new);
        float ps = 0.f;
#pragma unroll
        for (int i = 0; i < 8; ++i) { w[i] = fexp2(w[i] - m_new); ps += w[i]; }
        lsum = lsum * alpha + ps;
#pragma unroll
        for (int d = 0; d < NDS; ++d) { o[d][0] *= alpha; o[d][1] *= alpha; o[d][2] *= alpha; o[d][3] *= alpha; }
        m_run = m_new;
      }
      union { unsigned u[4]; bf16x8 v; } wb;
#pragma unroll
      for (int i = 0; i < 4; ++i) wb.u[i] = cvt_pk_bf16(w[2 * i], w[2 * i + 1]);
#pragma unroll
      for (int d = 0; d < NDS; ++d) {
        const bf16_t* vp = Vt + (d * 16 + fr) * VP + g * 32 + 4 * fq;
        union { uint2 h[2]; bf16x8 v; } a;
        a.h[0] = *(const uint2*)vp; a.h[1] = *(const uint2*)(vp + 16);
        o[d] = __builtin_amdgcn_mfma_f32_16x16x32_bf16(a.v, wb.v, o[d], 0, 0, 0);
      }
    }
    if (MODE == 1) {
      const int okw = __all(R < -150.0f);
      __syncthreads();
      if (lane == 0) flags[wid] = okw;
      __syncthreads();
      int all = 1;
#pragma unroll
      for (int i = 0; i < 8; ++i) all &= flags[i];
      if (all) break;
    }
  }

  float inv = 1.0f;
  if (MODE != 1) {
    lsum += __shfl_xor(lsum, 16); lsum += __shfl_xor(lsum, 32);
    if (MODE == 0) lsum += fexp2(p->swa_sinks[l * 8 + h] * LOG2E - m_run);
    inv = 1.0f / lsum;
  }
  const bf16_t* gp = p->proj + rowQ * INW + gcol + 4 * fq;
#pragma unroll
  for (int d = 0; d < NDS; ++d) {
    uint2 gv = *(const uint2*)(gp + d * 16);
    uint2 pk;
    pk.x = cvt_pk_bf16(o[d][0] * inv * siluf_(bflo(gv.x)), o[d][1] * inv * siluf_(bfhi(gv.x)));
    pk.y = cvt_pk_bf16(o[d][2] * inv * siluf_(bflo(gv.y)), o[d][3] * inv * siluf_(bfhi(gv.y)));
    *(uint2*)(qptr + d * 16 + 4 * fq) = pk;
  }
}

template <int APPLY>
__device__ void lru_item(PP p, int l, int bb, int ck, int nb) {
  bf16_t* cxs = (bf16_t*)smem;
  bf16_t* xcs = (bf16_t*)(smem + 16896);
  bf16_t* wta = (bf16_t*)(smem + 35328);
  bf16_t* wtx = (bf16_t*)(smem + 44544);
  float* as_ = (float*)(smem + 53760);
  float* bs_ = (float*)(smem + 86528);
  float* segA = (float*)(smem + 119296);
  float* segH = (float*)(smem + 121344);
  float* cin = (float*)(smem + 123392);
  const int tid = otid(), wid = tid >> 6, lane = tid & 63, fr = lane & 15, fq = lane >> 4;
  const long row0 = (long)bb * SEQ + ck * 128;
  __syncthreads();
  for (int s = tid; s < 131 * 8; s += 512) {
    const int r = s >> 3, cc = s & 7, t = ck * 128 + r - 3;
    uint4 u = make_uint4(0, 0, 0, 0);
    if (t >= 0) u = *(const uint4*)(p->proj + ((long)bb * SEQ + t) * INW + C_CX + nb * 64 + cc * 8);
    *(uint4*)(cxs + r * 64 + cc * 8) = u;
  }
  {
    const float* wa = p->lru_w_a + (long)(l * 8 + nb) * 4096;
    const float* wx = p->lru_w_x + (long)(l * 8 + nb) * 4096;
#pragma unroll
    for (int e = tid; e < 1024; e += 512) {
      const int cch = e >> 4, d4 = (e & 15) * 4;
      float4 va = *(const float4*)(wa + cch * 64 + d4);
      float4 vx = *(const float4*)(wx + cch * 64 + d4);
      wta[(d4 + 0) * 72 + cch] = f2bf(va.x); wta[(d4 + 1) * 72 + cch] = f2bf(va.y);
      wta[(d4 + 2) * 72 + cch] = f2bf(va.z); wta[(d4 + 3) * 72 + cch] = f2bf(va.w);
      wtx[(d4 + 0) * 72 + cch] = f2bf(vx.x); wtx[(d4 + 1) * 72 + cch] = f2bf(vx.y);
      wtx[(d4 + 2) * 72 + cch] = f2bf(vx.z); wtx[(d4 + 3) * 72 + cch] = f2bf(vx.w);
    }
  }
  __syncthreads();
  {
    const int ch = tid & 63, gch = nb * 64 + ch;
    const float* cw = p->conv_w + (long)l * 4 * 512 + gch;
    const float w0 = cw[0], w1 = cw[512], w2 = cw[1024], w3 = cw[1536], cb = p->conv_b[l * 512 + gch];
#pragma unroll
    for (int i = 0; i < 16; ++i) {
      const int tok = (tid >> 6) + 8 * i;
      const float v = cb + w0 * bf2f(cxs[(tok + 0) * 64 + ch]) + w1 * bf2f(cxs[(tok + 1) * 64 + ch]) +
                      w2 * bf2f(cxs[(tok + 2) * 64 + ch]) + w3 * bf2f(cxs[(tok + 3) * 64 + ch]);
      xcs[tok * 72 + ch] = f2bf(v);
    }
  }
  __syncthreads();
  {
    bf16x8 a[2];
#pragma unroll
    for (int ks = 0; ks < 2; ++ks) a[ks] = *(const bf16x8*)(xcs + (wid * 16 + fr) * 72 + ks * 32 + fq * 8);
#pragma unroll
    for (int nk = 0; nk < 4; ++nk) {
      f32x4 ra = f32x4{0.f, 0.f, 0.f, 0.f}, ia = f32x4{0.f, 0.f, 0.f, 0.f};
#pragma unroll
      for (int ks = 0; ks < 2; ++ks) {
        bf16x8 ba = *(const bf16x8*)(wta + (nk * 16 + fr) * 72 + ks * 32 + fq * 8);
        bf16x8 bx = *(const bf16x8*)(wtx + (nk * 16 + fr) * 72 + ks * 32 + fq * 8);
        ra = __builtin_amdgcn_mfma_f32_16x16x32_bf16(a[ks], ba, ra, 0, 0, 0);
        ia = __builtin_amdgcn_mfma_f32_16x16x32_bf16(a[ks], bx, ia, 0, 0, 0);
      }
      const int ch = nk * 16 + fr, gch = nb * 64 + ch;
      const float ba_ = p->lru_b_a[l * 512 + gch], bx_ = p->lru_b_x[l * 512 + gch];
      const float sp = log1pf(__expf(-p->lru_lambda[l * 512 + gch]));
      const float* cw = p->conv_w + (long)l * 4 * 512 + gch;
      const float w0 = cw[0], w1 = cw[512], w2 = cw[1024], w3 = cw[1536], cb = p->conv_b[l * 512 + gch];
#pragma unroll
      for (int reg = 0; reg < 4; ++reg) {
        const int tok = wid * 16 + 4 * fq + reg;
        const float r = sigmoidf_(ra[reg] + ba_), ig = sigmoidf_(ia[reg] + bx_);
        const float log_a = -8.0f * r * sp;
        const float av = __expf(log_a);
        const float mult = sqrtf(fmaxf(1.0f - __expf(2.0f * log_a), 0.f));
        const float xc = cb + w0 * bf2f(cxs[(tok + 0) * 64 + ch]) + w1 * bf2f(cxs[(tok + 1) * 64 + ch]) +
                         w2 * bf2f(cxs[(tok + 2) * 64 + ch]) + w3 * bf2f(cxs[(tok + 3) * 64 + ch]);
        as_[tok * 64 + ch] = av;
        bs_[tok * 64 + ch] = mult * ig * xc;
      }
    }
  }
  __syncthreads();
  {
    const int ch = tid & 63, seg = tid >> 6;
    float P = 1.f, hh = 0.f;
#pragma unroll
    for (int i = 0; i < 16; ++i) {
      const int idx = (seg * 16 + i) * 64 + ch;
      const float a = as_[idx], b = bs_[idx];
      hh = a * hh + b; P *= a;
      as_[idx] = P; bs_[idx] = hh;
    }
    segA[seg * 64 + ch] = P; segH[seg * 64 + ch] = hh;
  }
  __syncthreads();
  if (tid < 64) {
    const int ch = tid;
    float carry = 0.f;
    if (APPLY) {
      const float* pa = p->lruA + (long)(bb * 64) * 512 + nb * 64 + ch;
      const float* ph = p->lruH + (long)(bb * 64) * 512 + nb * 64 + ch;
#pragma unroll 4
      for (int cc = 0; cc < ck; ++cc) carry = pa[cc * 512] * carry + ph[cc * 512];
    }
    float At = 1.f;
#pragma unroll
    for (int sg = 0; sg < 8; ++sg) {
      cin[sg * 64 + ch] = carry;
      const float a = segA[sg * 64 + ch];
      carry = a * carry + segH[sg * 64 + ch]; At *= a;
    }
    if (!APPLY) {
      p->lruA[(long)(bb * 64 + ck) * 512 + nb * 64 + ch] = At;
      p->lruH[(long)(bb * 64 + ck) * 512 + nb * 64 + ch] = carry;
    }
  }
  if (APPLY) {
    __syncthreads();
    const int ch = tid & 63, seg = tid >> 6;
    const float c0 = cin[seg * 64 + ch];
#pragma unroll
    for (int i = 0; i < 16; ++i) {
      const int tok = seg * 16 + i, idx = tok * 64 + ch;
      const float hv = bs_[idx] + as_[idx] * c0;
      bf16_t* gp = p->proj + (row0 + tok) * INW + C_CG + nb * 64 + ch;
      *gp = f2bf(hv * siluf_(bf2f(*gp)));
    }
  }
}

__device__ void phase_mix1(PP p, int c, int l) {
  constexpr int N_SWA = CB * 64 * 8, N_MEM = CB * 64 * 4, N_LRU = CB * 64 * 8;
  for (int i = blockIdx.x; i < N_SWA + N_MEM + N_LRU; i += gridDim.x) {
    if (i < N_SWA) { const int h = i & 7, qb = (i >> 3) & 63, bb = i >> 9; attn_item<64, 0>(p, c, l, bb, qb, h); }
    else if (i < N_SWA + N_MEM) { const int j = i - N_SWA, h = j & 3, qb = (j >> 2) & 63, bb = j >> 8; attn_item<128, 2>(p, c, l, bb, qb, h); }
    else { const int j = i - N_SWA - N_MEM, nb = j & 7, ck = (j >> 3) & 63, bb = j >> 9; lru_item<0>(p, l, bb, ck, nb); }
  }
}
__device__ void phase_mix2(PP p, int c, int l) {
  constexpr int N_SB = CB * 64 * 8, N_LRU = CB * 64 * 8;
  for (int i = blockIdx.x; i < N_SB + N_LRU; i += gridDim.x) {
    if (i < N_SB) { const int h = i & 7, qb = (i >> 3) & 63, bb = i >> 9; attn_item<64, 1>(p, c, l, bb, qb, h); }
    else { const int j = i - N_SB, nb = j & 7, ck = (j >> 3) & 63, bb = j >> 9; lru_item<1>(p, l, bb, ck, nb); }
  }
}

__device__ __forceinline__ void grid_barrier(unsigned* bar, unsigned target) {
  asm volatile("s_waitcnt vmcnt(0) lgkmcnt(0)" ::: "memory");
  __syncthreads();
  if (threadIdx.x == 0) {
    __builtin_amdgcn_fence(__ATOMIC_RELEASE, "agent");
    __hip_atomic_fetch_add(bar, 1u, __ATOMIC_RELAXED, __HIP_MEMORY_SCOPE_AGENT);
    while (__hip_atomic_load(bar, __ATOMIC_RELAXED, __HIP_MEMORY_SCOPE_AGENT) < target) __builtin_amdgcn_s_sleep(2);
    __builtin_amdgcn_fence(__ATOMIC_ACQUIRE, "agent");
  }
  __syncthreads();
}

constexpr int NPHASE = 1 + NCHUNK * 2 * 5;
__global__ void __launch_bounds__(512) mega(Params p_arg, int ph_lo, int ph_hi) {
  cg::grid_group grid = cg::this_grid();
  unsigned* p_bar = ((PP)__builtin_amdgcn_kernarg_segment_ptr())->bar;
  unsigned nbar = 0;
#pragma unroll 1
  for (int ph = ph_lo; ph < ph_hi; ++ph) {
    if (ph > ph_lo) {
      if (ph_hi > 4096) grid.sync();
      grid_barrier(p_bar, (++nbar) * gridDim.x);
#if PROBE == 7
      grid_barrier(p_bar, (++nbar) * gridDim.x); grid_barrier(p_bar, (++nbar) * gridDim.x);
#endif
    }
    PP p = (PP)__builtin_amdgcn_kernarg_segment_ptr();
    asm volatile("" : "+s"(p));
    if (ph == 0) {
      int nrep = (PROBE == 6) ? 2 : 1; asm volatile("" : "+s"(nrep));
#pragma unroll 1
      for (int r = 0; r < nrep; ++r) { phase_prep(p); __syncthreads(); }
      continue;
    }
    const int q = ph - 1, kind = q % 5, cl = q / 5, c = cl >> 1, l = cl & 1;
    const int pk = (PROBE == 1) ? 0 : (PROBE == 2) ? 1 : (PROBE == 3) ? 2 : (PROBE == 4) ? 3 : -1;
    const int nsub = (PROBE != 0 && kind == 0) ? 2 : 1;
#pragma unroll 1
    for (int s = 0; s < nsub; ++s) {
      int kk = (s == nsub - 1) ? kind : pk;
      asm volatile("" : "+s"(kk));
      if (kk == 0) phase_g1(p, c, l);
      else if (kk == 1) phase_mix1(p, c, l);
      else if (kk == 2) phase_mix2(p, c, l);
      else if (kk == 3) phase_g2(p, c, l);
      else phase_g3(p, c, l);
      if (s < nsub - 1) __syncthreads();
    }
  }
}

extern "C" void kernel_launch(void* const* d_in, const int* in_sizes, int n_in, void* d_out, int out_size, void* d_ws,
                              size_t ws_size, hipStream_t stream) {
  static int grid_blocks = 0;
  if (!grid_blocks) {
    int dev = 0, cus = 0, per_cu = 0;
    hipGetDevice(&dev);
    hipDeviceGetAttribute(&cus, hipDeviceAttributeMultiprocessorCount, dev);
    hipFuncSetAttribute((const void*)mega, hipFuncAttributeMaxDynamicSharedMemorySize, LDS_BYTES);
    hipOccupancyMaxActiveBlocksPerMultiprocessor(&per_cu, (const void*)mega, 512, LDS_BYTES);
    if (per_cu < 1) per_cu = 1;
    grid_blocks = cus * 1;
    (void)hipGetLastError();
  }
  Params p{};
  const float* const* in = (const float* const*)d_in;
  p.x = in[0]; p.mem = in[1]; p.norm_gain = in[2]; p.w_in = in[3]; p.swa_q_gain = in[4]; p.swa_k_gain = in[5];
  p.swa_sinks = in[6]; p.conv_w = in[7]; p.conv_b = in[8]; p.lru_w_a = in[9]; p.lru_b_a = in[10]; p.lru_w_x = in[11];
  p.lru_b_x = in[12]; p.lru_lambda = in[13]; p.mem_norm_gain = in[14]; p.w_mem_kv = in[15]; p.mem_q_gain = in[16];
  p.mem_k_gain = in[17]; p.w_branch = in[18]; p.w_out = in[19];
  p.out = (float*)d_out;
  char* ws = (char*)d_ws; size_t off = 0;
  auto take = [&](size_t bytes) { char* r = ws + off; off += (bytes + 255) & ~(size_t)255; return r; };
  p.bar = (unsigned*)take(256);
  p.WinT = (bf16_t*)take((size_t)2 * INW * DM * 2);
  p.WbrT = (bf16_t*)take((size_t)8 * DM * 512 * 2);
  p.WoutT = (bf16_t*)take((size_t)2 * DM * DM * 2);
  p.WmkvT = (bf16_t*)take((size_t)2 * DM * DM * 2);
  p.xb = (bf16_t*)take((size_t)NTOK * DM * 2);
  p.memb = (bf16_t*)take((size_t)BATCH * 256 * DM * 2);
  p.mkv = (bf16_t*)take((size_t)2 * BATCH * 256 * DM * 2);
  p.ssq_x = (float*)take((size_t)2 * NTOK * 4);
  p.ssq_mem = (float*)take((size_t)BATCH * 256 * 4);
  p.lruA = (float*)take((size_t)CB * 64 * 512 * 4);
  p.lruH = (float*)take((size_t)CB * 64 * 512 * 4);
  p.proj = (bf16_t*)take((size_t)CT * INW * 2);
  if (off > ws_size) { fprintf(stderr, "kernel_launch: workspace too small: need %zu have %zu\n", off, ws_size); return; }
  (void)hipMemsetAsync(p.bar, 0, 256, stream);
#if COOP
  int lo = 0, hi = NPHASE;
  void* args[] = {&p, &lo, &hi};
  hipError_t e = hipLaunchCooperativeKernel((const void*)mega, dim3(grid_blocks), dim3(512), args, LDS_BYTES, stream);
  if (e != hipSuccess) fprintf(stderr, "cooperative launch failed: %s (grid %d)\n", hipGetErrorString(e), grid_blocks);
#else
  for (int ph = 0; ph < NPHASE; ++ph) mega<<<grid_blocks, 512, LDS_BYTES, stream>>>(p, ph, ph + 1);
#endif
}
```

```cpp
#include <hip/hip_runtime.h>
#include <hip/hip_cooperative_groups.h>
#include <cstdint>
#include <cstdio>
namespace cg = cooperative_groups;

#ifndef PM
#define PM 63
#endif
#ifndef PROBE
#define PROBE 0
#endif
#ifndef COOP
#define COOP 1
#endif

typedef unsigned short bf16_t;
typedef short bf16x8 __attribute__((ext_vector_type(8)));
typedef float f32x4 __attribute__((ext_vector_type(4)));

constexpr int DM = 1024, BATCH = 4, SEQ = 8192, NTOK = BATCH * SEQ, INW = 9472;
constexpr int CB = 2, CT = CB * SEQ, NCHUNK = BATCH / CB;
constexpr int C_AQ = 0, C_AK = 512, C_AV = 640, C_AG = 768, C_BQ = 1280, C_BK = 1792, C_BV = 2304, C_BG = 2816,
              C_CX = 3328, C_CG = 3840, C_MQ = 4352, C_MG = 4864, C_MRG = 5376,
              C_MIX = 7424;
constexpr int LDS_BYTES = 139264;
constexpr float EPS = 1e-6f;
constexpr float LOG2E = 1.4426950408889634f;

struct Params {
  const float *x, *mem, *norm_gain, *w_in, *swa_q_gain, *swa_k_gain, *swa_sinks, *conv_w, *conv_b,
      *lru_w_a, *lru_b_a, *lru_w_x, *lru_b_x, *lru_lambda, *mem_norm_gain, *w_mem_kv,
      *mem_q_gain, *mem_k_gain, *w_branch, *w_out;
  float* out;
  bf16_t *WinT, *WbrT, *WoutT, *WmkvT, *xb, *memb, *mkv, *proj;
  float *ssq_x, *ssq_mem, *lruA, *lruH;
  unsigned* bar;
  bf16_t* lruWT;
  unsigned long long* lruT;
  unsigned char *xb8, *Wg8;
};

typedef const __attribute__((address_space(4))) Params* PP;
extern __shared__ __attribute__((aligned(16))) char smem[];
constexpr int WIDTAB_OFF = 138240;
__device__ __forceinline__ int hw_wave_slot() { return (int)(__builtin_amdgcn_s_getreg((5 << 11) | 4) & 63u); }
__device__ __forceinline__ int otid() {
  const int wid = *(volatile __attribute__((address_space(3))) int*)((__attribute__((address_space(3))) char*)smem + WIDTAB_OFF + hw_wave_slot() * 4);
  unsigned ones = ~0u; asm volatile("" : "+s"(ones));
  int t = wid * 64 + (int)__builtin_amdgcn_mbcnt_hi(ones, __builtin_amdgcn_mbcnt_lo(ones, 0u));
  asm volatile("" : "+v"(t)); return t;
}

typedef __bf16 bf16v2 __attribute__((ext_vector_type(2)));
typedef float f32v2 __attribute__((ext_vector_type(2)));
__device__ __forceinline__ unsigned cvt_pk_bf16(float lo, float hi) {
  f32v2 v = {lo, hi};
  return __builtin_bit_cast(unsigned, __builtin_convertvector(v, bf16v2));
}
__device__ __forceinline__ bf16_t f2bf(float f) { return (bf16_t)(cvt_pk_bf16(f, 0.f) & 0xffffu); }
__device__ __forceinline__ float bf2f(bf16_t b) { return __uint_as_float(((unsigned)b) << 16); }
__device__ __forceinline__ float bflo(unsigned w) { return __uint_as_float(w << 16); }
__device__ __forceinline__ float bfhi(unsigned w) { return __uint_as_float(w & 0xffff0000u); }
__device__ __forceinline__ float fexp2(float x) { return __builtin_amdgcn_exp2f(x); }
__device__ __forceinline__ float flog2(float x) { return __builtin_amdgcn_logf(x); }
__device__ __forceinline__ float frcp(float x) { return __builtin_amdgcn_rcpf(x); }
__device__ __forceinline__ float sigmoidf_(float x) { return frcp(1.0f + fexp2(-x * LOG2E)); }
__device__ __forceinline__ float siluf_(float x) { return x * sigmoidf_(x); }
__device__ __forceinline__ float add_x16(float v) { auto r = __builtin_amdgcn_permlane16_swap(__float_as_uint(v), __float_as_uint(v), false, false); return __uint_as_float(r[0]) + __uint_as_float(r[1]); }
__device__ __forceinline__ float add_x32(float v) { auto r = __builtin_amdgcn_permlane32_swap(__float_as_uint(v), __float_as_uint(v), false, false); return __uint_as_float(r[0]) + __uint_as_float(r[1]); }
__device__ __forceinline__ float max_x16(float v) { auto r = __builtin_amdgcn_permlane16_swap(__float_as_uint(v), __float_as_uint(v), false, false); return fmaxf(__uint_as_float(r[0]), __uint_as_float(r[1])); }
__device__ __forceinline__ float max_x32(float v) { auto r = __builtin_amdgcn_permlane32_swap(__float_as_uint(v), __float_as_uint(v), false, false); return fmaxf(__uint_as_float(r[0]), __uint_as_float(r[1])); }
__device__ __forceinline__ float shx(float v, int mask, int lane) { return __int_as_float(__builtin_amdgcn_ds_bpermute((lane ^ mask) << 2, __float_as_int(v))); }

__device__ __forceinline__ int lds_byte(int r, int c) {
  int st = (r >> 4) * 2 + (c >> 5), rr = r & 15, cc = c & 31, ob = rr * 64 + cc * 2;
  return st * 1024 + (ob ^ (((ob >> 9) & 1) << 5));
}
__device__ __forceinline__ void stage_rc(int b, int& R, int& C) {
  int st = b / 1024, sb = b % 1024, swz = sb ^ (((sb >> 9) & 1) << 5);
  R = (st >> 1) * 16 + swz / 64; C = (st & 1) * 32 + (swz % 64) / 2;
}

#define WAIT_VN(N) asm volatile("s_waitcnt vmcnt(%0)" ::"n"(N) : "memory")
#define WAIT_L(n) asm volatile("s_waitcnt lgkmcnt(" #n ")" ::: "memory")
#define BAR __builtin_amdgcn_s_barrier()
#define SCHED __builtin_amdgcn_sched_barrier(0)

struct GUnit { const bf16_t* A; const bf16_t* B; };

template <int AM, bool FP8, class PH>
__device__ __forceinline__ void gemm_stream(PH& ph, const int nu, const int lda, const int ldb, const int K) {
  constexpr int LA = AM / 2, HA = 32 * AM;
  constexpr int W1 = 2 + LA, W2 = 4 + LA, W3 = LA;
  if (nu <= 0) return;
  const int tid = otid(), wid = tid >> 6, lane = tid & 63, wr = wid >> 2, wc = wid & 3, fr = lane & 15, fq = lane >> 4;
  unsigned aoff0, boff0;
  { int r, c; stage_rc(tid * 16, r, c); aoff0 = (unsigned)(r * lda + c) * 2u;
    const int rho = r & 31, pr = (r & ~31) + 8 * ((rho & 15) >> 2) + 4 * (rho >> 4) + (rho & 3);
    boff0 = (unsigned)(pr * ldb + c) * 2u; }
  const long a64 = (long)64 * lda, b64 = (long)64 * ldb;
  const long a1o = (long)HA * lda, b1o = (long)128 * ldb;
  int one_e8m0 = 127; asm volatile("" : "+s"(one_e8m0));
  const int ldsw = __builtin_amdgcn_readfirstlane(wid) * 1024;
#define SA_(b, h) (smem + ((b) * 2 + (h)) * 16384)
#define SB_(b, h) (smem + (4 + (b) * 2 + (h)) * 16384)
#define STG_A(b, h, base) do { _Pragma("unroll") for (int _i = 0; _i < LA; ++_i) \
    __builtin_amdgcn_global_load_lds((const unsigned*)((const char*)((base) + ((h) ? a1o : 0) + _i * a64) + aoff0), (unsigned*)(SA_(b, h) + ldsw + _i * 8192), 16, 0, 0); } while (0)
#define STG_B(b, h, base) do { _Pragma("unroll") for (int _i = 0; _i < 2; ++_i) \
    __builtin_amdgcn_global_load_lds((const unsigned*)((const char*)((base) + ((h) ? b1o : 0) + _i * b64) + boff0), (unsigned*)(SB_(b, h) + ldsw + _i * 8192), 16, 0, 0); } while (0)
  typedef int v4i_t __attribute__((ext_vector_type(4)));
  typedef int v8i_t __attribute__((ext_vector_type(8)));
  const int tsw = lds_byte(fr, fq * 8);
  const char* abase = smem + wr * (AM * 2048) + tsw;
  const char* bbase = smem + 65536 + wc * 4096 + tsw;
#define LDA_(dst, b, h) do { if (FP8) { _Pragma("unroll") for (int m = 0; m < AM; ++m) { \
      const v4i_t lo_ = *reinterpret_cast<const v4i_t*>(abase + (((b) * 2 + (h)) * 16384 + m * 2048)); \
      const v4i_t hi_ = *reinterpret_cast<const v4i_t*>(abase + (((b) * 2 + (h)) * 16384 + m * 2048 + 1024)); \
      dst##8[m] = __builtin_shufflevector(lo_, hi_, 0, 1, 2, 3, 4, 5, 6, 7); } \
    } else { _Pragma("unroll") for (int m = 0; m < AM; ++m) _Pragma("unroll") for (int k = 0; k < 2; ++k) \
    dst[m][k] = *reinterpret_cast<const bf16x8*>(abase + (((b) * 2 + (h)) * 16384 + m * 2048 + k * 1024)); } } while (0)
#define LDB_(dst, b, h) do { if (FP8) { _Pragma("unroll") for (int n = 0; n < 2; ++n) { \
      const v4i_t lo_ = *reinterpret_cast<const v4i_t*>(bbase + (((b) * 2 + (h)) * 16384 + n * 2048)); \
      const v4i_t hi_ = *reinterpret_cast<const v4i_t*>(bbase + (((b) * 2 + (h)) * 16384 + n * 2048 + 1024)); \
      dst##8[n] = __builtin_shufflevector(lo_, hi_, 0, 1, 2, 3, 4, 5, 6, 7); } \
    } else { _Pragma("unroll") for (int n = 0; n < 2; ++n) _Pragma("unroll") for (int k = 0; k < 2; ++k) \
    dst[n][k] = *reinterpret_cast<const bf16x8*>(bbase + (((b) * 2 + (h)) * 16384 + n * 2048 + k * 1024)); } } while (0)
#define MMA_(ai, bj, At, Bx) do { __builtin_amdgcn_s_setprio(1); \
    if (FP8) { \
      _Pragma("unroll") for (int m = 0; m < AM; ++m) _Pragma("unroll") for (int n = 0; n < 2; ++n) \
        acc[ai][bj][m][n] = __builtin_amdgcn_mfma_scale_f32_16x16x128_f8f6f4(Bx##8[n], At##8[m], acc[ai][bj][m][n], 0, 0, 0, one_e8m0, 0, one_e8m0); \
    } else { \
    _Pragma("unroll") for (int m = 0; m < AM; ++m) _Pragma("unroll") for (int n = 0; n < 2; ++n) _Pragma("unroll") for (int k = 0; k < 2; ++k) \
      acc[ai][bj][m][n] = __builtin_amdgcn_mfma_f32_16x16x32_bf16(Bx[n][k], At[m][k], acc[ai][bj][m][n], 0, 0, 0); \
    } \
    __builtin_amdgcn_s_setprio(0); } while (0)

  f32x4 acc[2][2][AM][2];
  bf16x8 At[AM][2], Bf0[2][2], Bf1[2][2];
  v8i_t At8[AM], Bf08[2], Bf18[2];
  const int nt = K / 64;
  GUnit cur = ph.unit(0);
  constexpr int WS = 4 + 2 * LA, WP0 = LA, WP1 = 4 + LA;
  STG_B(0, 0, cur.B); STG_B(0, 1, cur.B); STG_A(0, 0, cur.A); STG_A(0, 1, cur.A);
  if (wr == 1) BAR;
  WAIT_VN(WP0); BAR;
  STG_B(1, 0, cur.B + 64); STG_A(1, 0, cur.A + 64); STG_B(1, 1, cur.B + 64);
  WAIT_VN(WP1); BAR;
#pragma unroll 1
  for (int u = 0; u < nu; ++u) {
#pragma unroll
    for (int a = 0; a < 2; ++a)
#pragma unroll
      for (int b = 0; b < 2; ++b)
#pragma unroll
        for (int m = 0; m < AM; ++m)
#pragma unroll
          for (int n = 0; n < 2; ++n) acc[a][b][m][n] = f32x4{0.f, 0.f, 0.f, 0.f};
    if (u > 0) { if (wr == 1) BAR; }
    const bool has_next = (u + 1 < nu);
    GUnit nx = cur;
    if (has_next) nx = ph.unit(u + 1);
#pragma unroll 1
    for (int t = 0; t < nt; t += 2) {
      const bool lastp = (t == nt - 2);
      if (lastp) ph.preload(u);
      const bf16_t* pa2 = lastp ? nx.A : cur.A + (t + 2) * 64;
      const bf16_t* pb2 = lastp ? nx.B : cur.B + (t + 2) * 64;
      const bf16_t* pa1 = cur.A + (t + 1) * 64;
      LDB_(Bf0, 0, 0); LDB_(Bf1, 0, 1); SCHED; LDA_(At, 0, 0); STG_A(1, 1, pa1);
      WAIT_VN(WS); WAIT_L(0); BAR; MMA_(0, 0, At, Bf0); MMA_(0, 1, At, Bf1); BAR; SCHED;
      LDA_(At, 0, 1); STG_B(0, 0, pb2); STG_B(0, 1, pb2); STG_A(0, 0, pa2);
      WAIT_VN(WS); WAIT_L(0); BAR; MMA_(1, 0, At, Bf0); MMA_(1, 1, At, Bf1); BAR; SCHED;
      LDB_(Bf0, 1, 0); LDB_(Bf1, 1, 1); SCHED; LDA_(At, 1, 0); STG_A(0, 1, pa2);
      WAIT_VN(WS); WAIT_L(0); BAR; MMA_(0, 0, At, Bf0); MMA_(0, 1, At, Bf1); BAR; SCHED;
      LDA_(At, 1, 1); STG_B(1, 0, pb2 + 64); STG_B(1, 1, pb2 + 64); STG_A(1, 0, pa2 + 64);
      WAIT_VN(WS); WAIT_L(0); BAR; MMA_(1, 0, At, Bf0); MMA_(1, 1, At, Bf1); BAR; SCHED;
    }
    if (wr == 0) BAR;
    ph.epilogue(u, acc);
    cur = nx;
  }
  WAIT_VN(0);
  BAR;
}

__device__ __forceinline__ void tile_remap(int L, int nM, int nN, int& pm, int& pn) {
  const int nwg = nM * nN; int wgid = L;
  const int q = nwg / 8, r = nwg % 8, xcd = wgid % 8, off = wgid / 8;
  wgid = (xcd < r ? xcd * (q + 1) : r * (q + 1) + (xcd - r) * q) + off;
  const int nig = 8 * nN, gid = wgid / nig, fm = gid * 8, gsz = min(nM - fm, 8);
  pm = fm + ((wgid % nig) % gsz); pn = (wgid % nig) / gsz;
}

struct TDesc { const float* src; bf16_t* dst; unsigned char* dst8; const float* scale; float mul; int N, K, k0, n0; };
__device__ __forceinline__ TDesc prep_desc(PP p, int u) {
  constexpr int U_IN = 16 * 84, U_BR = 8 * 16, U_SQ = 16 * 16, U_G8 = 16 * 64;
  TDesc t; t.dst8 = nullptr; t.mul = 1.0f;
  if (u < 2 * U_IN) {
    const int l = u / U_IN, v = u % U_IN;
    t.src = p->w_in + (long)l * DM * INW; t.N = INW; t.dst = p->WinT + (long)l * INW * DM; t.K = DM; t.k0 = (v / 84) * 64; t.n0 = (v % 84) * 64; t.scale = p->norm_gain + l * DM;
  } else if (u < 2 * U_IN + 8 * U_BR) {
    const int v = u - 2 * U_IN, ln = v / U_BR, w = v % U_BR;
    t.src = p->w_branch + (long)ln * 512 * DM; t.N = DM; t.dst = p->WbrT + (long)ln * DM * 512; t.K = 512; t.k0 = (w / 16) * 64; t.n0 = (w % 16) * 64; t.scale = nullptr;
  } else if (u < 2 * U_IN + 8 * U_BR + 2 * U_SQ) {
    const int v = u - (2 * U_IN + 8 * U_BR), l = v / U_SQ, w = v % U_SQ;
    t.src = p->w_out + (long)l * DM * DM; t.N = DM; t.dst = p->WoutT + (long)l * DM * DM; t.K = DM; t.k0 = (w / 16) * 64; t.n0 = (w % 16) * 64; t.scale = nullptr;
  } else if (u < 2 * U_IN + 8 * U_BR + 4 * U_SQ) {
    const int v = u - (2 * U_IN + 8 * U_BR + 2 * U_SQ), l = v / U_SQ, w = v % U_SQ;
    t.src = p->w_mem_kv + (long)l * DM * DM; t.N = DM; t.dst = p->WmkvT + (long)l * DM * DM; t.K = DM; t.k0 = (w / 16) * 64; t.n0 = (w % 16) * 64; t.scale = p->mem_norm_gain + l * DM;
  } else if (u < 2 * U_IN + 8 * U_BR + 4 * U_SQ + 2 * U_G8) {
    const int v = u - (2 * U_IN + 8 * U_BR + 4 * U_SQ), l = v / U_G8, w = v % U_G8;
    t.src = p->w_in + (long)l * DM * INW + C_MRG; t.N = INW; t.dst = nullptr; t.dst8 = p->Wg8 + (long)l * 4096 * DM; t.K = DM; t.k0 = (w / 64) * 64; t.n0 = (w % 64) * 64;
    t.scale = p->norm_gain + l * DM; t.mul = 32.0f;
  } else {
    const int v = u - (2 * U_IN + 8 * U_BR + 4 * U_SQ + 2 * U_G8), which = v & 1, lnb = v >> 1;
    t.src = (which ? p->lru_w_x : p->lru_w_a) + (long)lnb * 4096; t.N = 64; t.dst = p->lruWT + (long)v * 4096; t.K = 64; t.k0 = 0; t.n0 = 0; t.scale = nullptr;
  }
  return t;
}

__device__ void phase_prep(PP p) {
  const int tid = otid(), wid = tid >> 6, lane = tid & 63;
  constexpr int NU = 2 * 16 * 84 + 8 * 8 * 16 + 4 * 16 * 16 + 2 * 16 * 64 + 32, TB = 8;
  const int upw = (NU + (int)gridDim.x - 1) / (int)gridDim.x;
  const int ubeg = min((int)blockIdx.x * upw, NU), uend = min(ubeg + upw, NU);
  for (int base = ubeg; base < uend; base += TB) {
    __syncthreads();
#pragma unroll
    for (int j = 0; j < TB; ++j) {
      if (base + j < uend) {
        const TDesc t = prep_desc(p, base + j);
        float* tile = (float*)smem + j * (64 * 65);
#pragma unroll
        for (int e = tid; e < 1024; e += 512) {
          const int kk = e >> 4, n4 = (e & 15) * 4;
          float4 v = *(const float4*)(t.src + (long)(t.k0 + kk) * t.N + t.n0 + n4);
          if (t.scale) { const float sc = t.scale[t.k0 + kk] * t.mul; v.x *= sc; v.y *= sc; v.z *= sc; v.w *= sc; }
          float* d = tile + kk * 65 + n4;
          d[0] = v.x; d[1] = v.y; d[2] = v.z; d[3] = v.w;
        }
      }
    }
    __syncthreads();
#pragma unroll
    for (int j = 0; j < TB; ++j) {
      if (base + j < uend) {
        const TDesc t = prep_desc(p, base + j);
        const float* tile = (const float*)smem + j * (64 * 65);
        if (t.dst8) {
#pragma unroll
          for (int e = tid; e < 1024; e += 512) {
            const int nn = e >> 4, kk = (e & 15) * 4;
            unsigned w8 = 0;
            w8 = __builtin_amdgcn_cvt_pk_fp8_f32(tile[kk * 65 + nn], tile[(kk + 1) * 65 + nn], w8, false);
            w8 = __builtin_amdgcn_cvt_pk_fp8_f32(tile[(kk + 2) * 65 + nn], tile[(kk + 3) * 65 + nn], w8, true);
            *(unsigned*)(t.dst8 + (long)(t.n0 + nn) * t.K + t.k0 + kk) = w8;
          }
        } else {
#pragma unroll
        for (int e = tid; e < 2048; e += 512) {
          const int nn = e >> 5, kk = (e & 31) * 2;
          *(unsigned*)(t.dst + (long)(t.n0 + nn) * t.K + t.k0 + kk) = cvt_pk_bf16(tile[kk * 65 + nn], tile[(kk + 1) * 65 + nn]);
        }
        }
      }
    }
  }
  for (int r0 = (blockIdx.x * 8 + wid) * 2; r0 < NTOK + BATCH * 256; r0 += gridDim.x * 16) {
    const float* src[2]; bf16_t* dst[2]; float* sq[2]; float4 v[2][4];
#pragma unroll
    for (int q = 0; q < 2; ++q) {
      const int r = r0 + q;
      if (r < NTOK) { src[q] = p->x + (long)r * DM; dst[q] = p->xb + (long)r * DM; sq[q] = p->ssq_x + r; }
      else { const int m = r - NTOK; src[q] = p->mem + (long)m * DM; dst[q] = p->memb + (long)m * DM; sq[q] = p->ssq_mem + m; }
#pragma unroll
      for (int i = 0; i < 4; ++i) v[q][i] = *(const float4*)(src[q] + (i * 64 + lane) * 4);
    }
#pragma unroll
    for (int q = 0; q < 2; ++q) {
      float ss = 0.f;
#pragma unroll
      for (int i = 0; i < 4; ++i) {
        const float4 w = v[q][i];
        ss += w.x * w.x + w.y * w.y + w.z * w.z + w.w * w.w;
        uint2 pk; pk.x = cvt_pk_bf16(w.x, w.y); pk.y = cvt_pk_bf16(w.z, w.w);
        *(uint2*)(dst[q] + (i * 64 + lane) * 4) = pk;
        if (r0 + q < NTOK) {
          unsigned w8 = 0;
          w8 = __builtin_amdgcn_cvt_pk_fp8_f32(w.x, w.y, w8, false); w8 = __builtin_amdgcn_cvt_pk_fp8_f32(w.z, w.w, w8, true);
          *(unsigned*)(p->xb8 + (long)(r0 + q) * DM + (i * 64 + lane) * 4) = w8;
        }
      }
#pragma unroll
      for (int o = 32; o >= 1; o >>= 1) ss += shx(ss, o, lane);
      if (lane == 0) *sq[q] = ss;
    }
  }
  for (int i = blockIdx.x * 512 + tid; i < NTOK; i += gridDim.x * 512) p->ssq_x[NTOK + i] = 0.f;
}

struct G1Phase {
  PP p; int c, l, wr, wc, fr, fq; int dry;
  static constexpr int nM = CT / 256, nN = C_MRG / 256, NT1 = nM * nN;
  __device__ __forceinline__ void locate(int u, const bf16_t*& A, const bf16_t*& Bt, const float*& ssq, bf16_t*& out, int& ldo) const {
    const int i = blockIdx.x + u * gridDim.x;
    if (i < NT1) {
      int pm, pn; tile_remap(i, nM, nN, pm, pn);
      pn = nN - 1 - pn;
      A = p->xb + ((long)c * CT + pm * 256) * DM; Bt = p->WinT + ((long)l * INW + pn * 256) * DM;
      ssq = p->ssq_x + (long)l * NTOK + c * CT + pm * 256; out = p->proj + (long)pm * 256 * INW + pn * 256; ldo = INW;
    } else {
      const int j = i - NT1, ll = j >> 4, pm = (j & 15) >> 2, pn = j & 3;
      A = p->memb + (long)pm * 256 * DM; Bt = p->WmkvT + ((long)ll * DM + pn * 256) * DM;
      ssq = p->ssq_mem + pm * 256; out = p->mkv + ((long)ll * 1024 + pm * 256) * DM + pn * 256; ldo = DM;
    }
  }
  __device__ __forceinline__ GUnit unit(int u) const {
    const bf16_t *A, *Bt; const float* ssq; bf16_t* out; int ldo;
    locate(u, A, Bt, ssq, out, ldo);
    return GUnit{A, Bt};
  }
  float ssqp[2][4];
  __device__ __forceinline__ void preload(int u) {
    const bf16_t *A, *Bt; const float* ssq; bf16_t* out; int ldo;
    locate(u, A, Bt, ssq, out, ldo);
    const int t_ = otid(), w_ = t_ >> 6, l_ = t_ & 63, wr = w_ >> 2, fr = l_ & 15;
#pragma unroll
    for (int ai = 0; ai < 2; ++ai)
#pragma unroll
      for (int m = 0; m < 4; ++m) ssqp[ai][m] = ssq[ai * 128 + wr * 64 + m * 16 + fr];
  }
  __device__ __forceinline__ void epilogue(int u, f32x4 (&acc)[2][2][4][2]) const {
    const bf16_t *A, *Bt; const float* ssq; bf16_t* out; int ldo;
    locate(u, A, Bt, ssq, out, ldo);
    const int tcol = (int)((out - p->proj) % INW);
    const bool gate_tile = (ldo == INW) && tcol >= C_MRG;
    char* grow = (char*)(out - tcol);
    const int gcol0 = 2 * C_MRG + (tcol - C_MRG);
    const int t_ = otid(), w_ = t_ >> 6, l_ = t_ & 63, wr = w_ >> 2, wc = w_ & 3, fr = l_ & 15, fq = l_ >> 4;
#pragma unroll
    for (int ai = 0; ai < 2; ++ai)
#pragma unroll
      for (int m = 0; m < 4; ++m) {
        const int r = ai * 128 + wr * 64 + m * 16 + fr;
        const float rs = rsqrtf(ssqp[ai][m] * (1.0f / DM) + EPS);
        const unsigned ob = (unsigned)r * (unsigned)ldo + wc * 32 + fq * 8;
#pragma unroll
        for (int bj = 0; bj < 2; ++bj) {
          uint4 pk; uint2 gq;
#pragma unroll
          for (int n = 0; n < 2; ++n) {
            f32x4 v = acc[ai][bj][m][n];
            v[0] *= rs; v[1] *= rs; v[2] *= rs; v[3] *= rs;
            if (gate_tile) {
              const unsigned q0 = (unsigned)fminf(sigmoidf_(v[0]) * 256.f, 255.f), q1 = (unsigned)fminf(sigmoidf_(v[1]) * 256.f, 255.f);
              const unsigned q2 = (unsigned)fminf(sigmoidf_(v[2]) * 256.f, 255.f), q3 = (unsigned)fminf(sigmoidf_(v[3]) * 256.f, 255.f);
              const unsigned w = q0 | (q1 << 8) | (q2 << 16) | (q3 << 24);
              if (n == 0) gq.x = w; else gq.y = w;
            } else {
              if (n == 0) { pk.x = cvt_pk_bf16(v[0], v[1]); pk.y = cvt_pk_bf16(v[2], v[3]); }
              else { pk.z = cvt_pk_bf16(v[0], v[1]); pk.w = cvt_pk_bf16(v[2], v[3]); }
            }
          }
          if (!dry) {
            if (gate_tile) *(uint2*)(grow + ((unsigned)r * (unsigned)(INW * 2) + (unsigned)(gcol0 + bj * 128 + wc * 32 + fq * 8))) = gq;
            else *(uint4*)(out + (ob + bj * 128)) = pk;
          }
        }
      }
  }
};
struct G1bPhase {
  PP p; int c, l, wr, wc, fr, fq;
  __device__ __forceinline__ void tile(int u, int& pm, int& pn) const { tile_remap(blockIdx.x + u * gridDim.x, CT / 256, 16, pm, pn); }
  __device__ __forceinline__ GUnit unit(int u) const {
    int pm, pn; tile(u, pm, pn);
    return GUnit{(const bf16_t*)(p->xb8 + ((long)c * CT + pm * 256) * DM), (const bf16_t*)(p->Wg8 + ((long)l * 4096 + pn * 256) * DM)};
  }
  __device__ __forceinline__ void preload(int) const {}
  __device__ __forceinline__ void epilogue(int u, f32x4 (&acc)[2][2][4][2]) const {
    int pm, pn; tile(u, pm, pn);
    const float* ssq = p->ssq_x + (long)l * NTOK + c * CT + pm * 256;
    char* grow = (char*)(p->proj + (long)pm * 256 * INW) + 2 * C_MRG + pn * 256;
    const int t_ = otid(), w_ = t_ >> 6, l_ = t_ & 63, wr = w_ >> 2, wc = w_ & 3, fr = l_ & 15, fq = l_ >> 4;
    float k256 = 256.f, k255 = 255.f; asm volatile("" : "+v"(k256), "+v"(k255));
#pragma unroll
    for (int ai = 0; ai < 2; ++ai)
#pragma unroll
      for (int m = 0; m < 4; ++m) {
        const unsigned r = ai * 128 + wr * 64 + m * 16 + fr;
        const float rs = rsqrtf(ssq[r] * (1.0f / DM) + EPS) * (1.0f / 32.0f);
#pragma unroll
        for (int bj = 0; bj < 2; ++bj) {
          uint2 gq;
#pragma unroll
          for (int n = 0; n < 2; ++n) {
            const f32x4 v = acc[ai][bj][m][n];
            const unsigned q0 = (unsigned)fminf(sigmoidf_(v[0] * rs) * k256, k255), q1 = (unsigned)fminf(sigmoidf_(v[1] * rs) * k256, k255);
            const unsigned q2 = (unsigned)fminf(sigmoidf_(v[2] * rs) * k256, k255), q3 = (unsigned)fminf(sigmoidf_(v[3] * rs) * k256, k255);
            const unsigned w = q0 | (q1 << 8) | (q2 << 16) | (q3 << 24);
            if (n == 0) gq.x = w; else gq.y = w;
          }
          *(uint2*)(grow + (r * (unsigned)(INW * 2) + (unsigned)(bj * 128 + wc * 32 + fq * 8))) = gq;
        }
      }
  }
};
__device__ void phase_g1(PP p, int c, int l, int dry) {
  {
    const int tid = otid(), wid = tid >> 6, lane = tid & 63;
    G1bPhase pb;
    pb.p = p; pb.c = c; pb.l = l; pb.wr = wid >> 2; pb.wc = wid & 3; pb.fr = lane & 15; pb.fq = lane >> 4;
    const int nub = ((CT / 256) * 16 - (int)blockIdx.x + (int)gridDim.x - 1) / (int)gridDim.x;
    gemm_stream<4, true>(pb, nub, DM / 2, DM / 2, DM / 2);
  }
  const int tid = otid(), wid = tid >> 6, lane = tid & 63;
  G1Phase ph;
  ph.dry = dry; ph.p = p; ph.c = c; ph.l = l; ph.wr = wid >> 2; ph.wc = wid & 3; ph.fr = lane & 15; ph.fq = lane >> 4;
  const int ntiles = G1Phase::NT1 + ((c == 0 && l == 0) ? 32 : 0);
  const int nu = (ntiles - (int)blockIdx.x + (int)gridDim.x - 1) / (int)gridDim.x;
  gemm_stream<4, false>(ph, nu, DM, DM, DM);
}

struct G2Phase {
  PP p; int l, wr, wc, fr, fq;
  f32x4 mix[2][2][2][2];
  uint2 gpre[2][2][2];
  __device__ __forceinline__ void preload(int u) {
    const int i = blockIdx.x + (u >> 2) * gridDim.x, n4 = u & 3, pm = i >> 2, pn = i & 3;
    const char* gu = (const char*)(p->proj + (long)pm * 128 * INW) + 2 * C_MRG + n4 * DM + pn * 256;
    int fr = this->fr; asm volatile("" : "+v"(fr));
#pragma unroll
    for (int ai = 0; ai < 2; ++ai)
#pragma unroll
      for (int m = 0; m < 2; ++m) {
        const unsigned ob = (unsigned)(ai * 64 + wr * 32 + m * 16 + fr) * (unsigned)(INW * 2) + wc * 32 + fq * 8;
#pragma unroll
        for (int bj = 0; bj < 2; ++bj) gpre[ai][bj][m] = *(const uint2*)(gu + (ob + bj * 128));
      }
  }
  __device__ __forceinline__ GUnit unit(int u) const {
    const int i = blockIdx.x + (u >> 2) * gridDim.x, n4 = u & 3, pm = i >> 2, pn = i & 3;
    const int bcol = (n4 == 0) ? C_AQ : (n4 == 1) ? C_BQ : (n4 == 2) ? C_CG : C_MQ;
    return GUnit{p->proj + (long)pm * 128 * INW + bcol, p->WbrT + ((long)(l * 4 + n4) * DM + pn * 256) * 512};
  }
  __device__ __forceinline__ void epilogue(int u, f32x4 (&acc)[2][2][2][2]) {
    const int i = blockIdx.x + (u >> 2) * gridDim.x, n4 = u & 3, pm = i >> 2, pn = i & 3;
    bf16_t* prow = p->proj + (long)pm * 128 * INW;
    int fr = this->fr; asm volatile("" : "+v"(fr));
#pragma unroll
    for (int ai = 0; ai < 2; ++ai)
#pragma unroll
      for (int m = 0; m < 2; ++m)
#pragma unroll
        for (int bj = 0; bj < 2; ++bj) {
          const uint2 gv = gpre[ai][bj][m];
#pragma unroll
          for (int n = 0; n < 2; ++n) {
            const unsigned gw = n ? gv.y : gv.x;
            f32x4 v = acc[ai][bj][m][n];
            f32x4 mv = (n4 == 0) ? f32x4{0.f, 0.f, 0.f, 0.f} : mix[ai][bj][m][n];
            mv[0] += ((float)(gw & 255u) + 0.5f) * (1.0f / 256.0f) * v[0];
            mv[1] += ((float)((gw >> 8) & 255u) + 0.5f) * (1.0f / 256.0f) * v[1];
            mv[2] += ((float)((gw >> 16) & 255u) + 0.5f) * (1.0f / 256.0f) * v[2];
            mv[3] += ((float)(gw >> 24) + 0.5f) * (1.0f / 256.0f) * v[3];
            mix[ai][bj][m][n] = mv;
          }
        }
    if (n4 == 3) {
#pragma unroll
      for (int ai = 0; ai < 2; ++ai)
#pragma unroll
        for (int m = 0; m < 2; ++m) {
          const int r = ai * 64 + wr * 32 + m * 16 + fr;
          bf16_t* o = prow + (long)r * INW + C_MIX + pn * 256 + wc * 32 + fq * 8;
#pragma unroll
          for (int bj = 0; bj < 2; ++bj) {
            const f32x4 v0 = mix[ai][bj][m][0], v1 = mix[ai][bj][m][1];
            uint4 pk; pk.x = cvt_pk_bf16(v0[0], v0[1]); pk.y = cvt_pk_bf16(v0[2], v0[3]); pk.z = cvt_pk_bf16(v1[0], v1[1]); pk.w = cvt_pk_bf16(v1[2], v1[3]);
            *(uint4*)(o + bj * 128) = pk;
          }
        }
    }
  }
};
__device__ void phase_g2(PP p, int c, int l) {
  const int tid = otid(), wid = tid >> 6, lane = tid & 63;
  G2Phase ph;
  ph.p = p; ph.l = l; ph.wr = wid >> 2; ph.wc = wid & 3; ph.fr = lane & 15; ph.fq = lane >> 4;
#pragma unroll
  for (int a = 0; a < 2; ++a)
#pragma unroll
    for (int b = 0; b < 2; ++b)
#pragma unroll
      for (int m = 0; m < 2; ++m)
#pragma unroll
        for (int n = 0; n < 2; ++n) ph.mix[a][b][m][n] = f32x4{0.f, 0.f, 0.f, 0.f};
  constexpr int NT = (CT / 128) * 4;
  const int ntl = (NT - (int)blockIdx.x + (int)gridDim.x - 1) / (int)gridDim.x;
  gemm_stream<2, false>(ph, ntl * 4, INW, 512, 512);
}

struct G3Phase {
  PP p; int c, l, wr, wc, fr, fq;
  __device__ __forceinline__ GUnit unit(int u) const {
    const int i = blockIdx.x + u * gridDim.x, pm = i >> 2, pn = i & 3;
    return GUnit{p->proj + (long)pm * 256 * INW + C_MIX, p->WoutT + ((long)l * DM + pn * 256) * DM};
  }
  __device__ __forceinline__ void preload(int) const {}
  __device__ __forceinline__ void epilogue(int u, f32x4 (&acc)[2][2][4][2]) const {
    const int i = blockIdx.x + u * gridDim.x, pm = i >> 2, pn = i & 3;
    const long ubase = ((long)c * CT + pm * 256) * DM + pn * 256;
    const float* xu = ((l == 0) ? p->x : p->out) + ubase;
    float* ou = p->out + ubase;
    bf16_t* xbu = p->xb + ubase;
    unsigned char* x8u = p->xb8 + ubase;
    float* squ = p->ssq_x + NTOK + (long)c * CT + pm * 256;
    int fr = this->fr; asm volatile("" : "+v"(fr));
#pragma unroll
    for (int ai = 0; ai < 2; ++ai)
#pragma unroll
      for (int m = 0; m < 4; ++m) {
        const unsigned rl = ai * 128 + wr * 64 + m * 16 + fr;
        const unsigned ob = rl * DM + wc * 32 + fq * 8;
        float ss = 0.f;
#pragma unroll
        for (int bj = 0; bj < 2; ++bj) {
          uint4 pk; uint2 q8;
#pragma unroll
          for (int n = 0; n < 2; ++n) {
            const unsigned off = ob + bj * 128 + n * 4;
            float4 xo = *(const float4*)(xu + off);
            f32x4 v = acc[ai][bj][m][n];
            float4 xn; xn.x = xo.x + v[0]; xn.y = xo.y + v[1]; xn.z = xo.z + v[2]; xn.w = xo.w + v[3];
            *(float4*)(ou + off) = xn;
            if (l == 0) {
              if (n == 0) { pk.x = cvt_pk_bf16(xn.x, xn.y); pk.y = cvt_pk_bf16(xn.z, xn.w); }
              else { pk.z = cvt_pk_bf16(xn.x, xn.y); pk.w = cvt_pk_bf16(xn.z, xn.w); }
              ss += xn.x * xn.x + xn.y * xn.y + xn.z * xn.z + xn.w * xn.w;
              unsigned w8 = 0;
              w8 = __builtin_amdgcn_cvt_pk_fp8_f32(xn.x, xn.y, w8, false); w8 = __builtin_amdgcn_cvt_pk_fp8_f32(xn.z, xn.w, w8, true);
              if (n == 0) q8.x = w8; else q8.y = w8;
            }
          }
          if (l == 0) {
            *(uint4*)(xbu + (ob + bj * 128)) = pk;
            *(uint2*)(x8u + (ob + bj * 128)) = q8;
          }
        }
        if (l == 0) {
          ss = add_x32(add_x16(ss));
          if (fq == 0) atomicAdd(squ + rl, ss);
        }
      }
  }
};
__device__ void phase_g3(PP p, int c, int l) {
  const int tid = otid(), wid = tid >> 6, lane = tid & 63;
  G3Phase ph{p, c, l, wid >> 2, wid & 3, lane & 15, lane >> 4};
  constexpr int NT = (CT / 256) * 4;
  const int nu = (NT - (int)blockIdx.x + (int)gridDim.x - 1) / (int)gridDim.x;
  gemm_stream<4, false>(ph, nu, INW, DM, DM);
}

template <int D, int MODE>
__device__ void attn_item(PP p, int c, int l, int bb, int qb0, int h0) {
  constexpr int NSUB = (MODE == 0) ? 4 : (MODE == 2) ? 2 : 1;
  constexpr int KP = D + 8, VP = 264, NKS = D / 32, NDS = D / 16;
  constexpr int TPR = D / 8, RPP = 512 / TPR, NPK = 256 / RPP, NPV = NPK / 2;
  bf16_t* Ks = (bf16_t*)smem;
  bf16_t* Vt = (bf16_t*)(smem + 256 * KP * 2);
  int* flags = (int*)(smem + 256 * KP * 2 + D * VP * 2);
  const int tid = otid(), wid = tid >> 6, lane = tid & 63, fr = lane & 15, fq = lane >> 4;
  const float sc = LOG2E * (D == 64 ? 0.125f : 0.08838834764831845f);
  const bf16_t *Kbase, *Vbase; int ldk; const float* kg = nullptr;
  if (MODE == 0) { Kbase = p->proj + (long)bb * SEQ * INW + C_AK + (h0 >> 2) * 64; Vbase = p->proj + (long)bb * SEQ * INW + C_AV + (h0 >> 2) * 64; ldk = INW; kg = p->swa_k_gain + l * 64; }
  else if (MODE == 1) { Kbase = p->proj + (long)bb * SEQ * INW + C_BK + h0 * 64; Vbase = p->proj + (long)bb * SEQ * INW + C_BV + h0 * 64; ldk = INW; }
  else { const int gb = c * CB + bb; Kbase = p->mkv + ((long)l * 1024 + gb * 256) * DM + h0 * 128; Vbase = Kbase + 512; ldk = DM; kg = p->mem_k_gain + l * 128; }

#pragma unroll 1
  for (int sub = 0; sub < NSUB; ++sub) {
  const int h = h0 + ((MODE == 0) ? sub : 0), qb = qb0 + ((MODE == 2) ? sub : 0);
  const int qcol = (MODE == 0 ? C_AQ : MODE == 1 ? C_BQ : C_MQ) + h * D;
  const int gcol = (MODE == 0 ? C_AG : MODE == 1 ? C_BG : C_MG) + h * D;
  const long rowQ = (long)bb * SEQ + qb * 128 + wid * 16 + fr;
  bf16_t* qptr = p->proj + rowQ * INW + qcol;
  const int qi = wid * 16 + fr;

  int krow0, nk;
  if (MODE == 2) { krow0 = 0; nk = 256; } else if (qb > 0) { krow0 = qb * 128 - 128; nk = 256; } else { krow0 = 0; nk = 128; }
  const int cc = tid % TPR, trow = tid / TPR;
  uint4 kreg[NPK], vreg[NPV][2];
  bool first = true;
#define ATTN_ISSUE_LOADS_() do { \
    _Pragma("unroll") for (int ps = 0; ps < NPK; ++ps) \
      if (ps * RPP < nk) kreg[ps] = *(const uint4*)(Kbase + (long)(krow0 + ps * RPP + trow) * ldk + cc * 8); \
    _Pragma("unroll") for (int ps = 0; ps < NPV; ++ps) \
      if (ps * 2 * RPP < nk) { \
        const bf16_t* vs = Vbase + (long)(krow0 + ps * 2 * RPP + 2 * trow) * ldk + cc * 8; \
        vreg[ps][0] = *(const uint4*)vs; vreg[ps][1] = *(const uint4*)(vs + ldk); \
      } } while (0)
  if (sub == 0) ATTN_ISSUE_LOADS_();
  uint2 gvp[NDS];
  {
    const bf16_t* gp0 = p->proj + rowQ * INW + gcol + 4 * fq;
#pragma unroll
    for (int d = 0; d < NDS; ++d) gvp[d] = *(const uint2*)(gp0 + d * 16);
  }
  bf16x8 qf[NKS];
  {
    float qv[NKS][8]; float ss = 0.f;
#pragma unroll
    for (int ks = 0; ks < NKS; ++ks) {
      uint4 u = *(const uint4*)(qptr + ks * 32 + fq * 8);
      qv[ks][0] = bflo(u.x); qv[ks][1] = bfhi(u.x); qv[ks][2] = bflo(u.y); qv[ks][3] = bfhi(u.y);
      qv[ks][4] = bflo(u.z); qv[ks][5] = bfhi(u.z); qv[ks][6] = bflo(u.w); qv[ks][7] = bfhi(u.w);
#pragma unroll
      for (int i = 0; i < 8; ++i) ss += qv[ks][i] * qv[ks][i];
    }
    float rs = sc;
    const float* qg = (MODE == 0) ? (p->swa_q_gain + l * 64) : (p->mem_q_gain + l * 128);
    if (MODE != 1) {
      ss = add_x32(add_x16(ss));
      rs = rsqrtf(ss * (1.0f / D) + EPS) * sc;
    }
#pragma unroll
    for (int ks = 0; ks < NKS; ++ks) {
      float g[8];
#pragma unroll
      for (int i = 0; i < 8; ++i) g[i] = (MODE != 1) ? qg[ks * 32 + fq * 8 + i] * rs : rs;
      union { unsigned u[4]; bf16x8 v; } cv;
#pragma unroll
      for (int i = 0; i < 4; ++i) cv.u[i] = cvt_pk_bf16(qv[ks][2 * i] * g[2 * i], qv[ks][2 * i + 1] * g[2 * i + 1]);
      qf[ks] = cv.v;
    }
  }

  bf16x8 uop[2];
  if (MODE == 1) {
    int onev = 0x3F80; asm volatile("" : "+v"(onev));
#pragma unroll
    for (int ss_ = 0; ss_ < 2; ++ss_) {
      const int srow = ss_ * 16 + fr;
#pragma unroll
      for (int i = 0; i < 8; ++i) {
        const int j = (i < 4) ? (4 * fq + i) : (16 + 4 * fq + (i - 4));
        uop[ss_][i] = (j >= srow) ? (short)onev : (short)0;
      }
    }
  }

  f32x4 o[NDS];
#pragma unroll
  for (int d = 0; d < NDS; ++d) o[d] = f32x4{0.f, 0.f, 0.f, 0.f};
  float m_run = -1e30f, lsum = 0.f, R = 0.f;
  if (MODE == 0) m_run = p->swa_sinks[l * 8 + h] * LOG2E;

  bool wdone = false;
#pragma unroll 1
  for (;;) {
    if (sub == 0) {
    __syncthreads();
    {
      if (!first) ATTN_ISSUE_LOADS_();
      first = false;
#pragma unroll
      for (int ps = 0; ps < NPK; ++ps)
        if (ps * RPP < nk) {
          uint4 u = kreg[ps];
          if (MODE != 1) {
            float f[8] = {bflo(u.x), bfhi(u.x), bflo(u.y), bfhi(u.y), bflo(u.z), bfhi(u.z), bflo(u.w), bfhi(u.w)};
            float ss = 0.f;
#pragma unroll
            for (int i = 0; i < 8; ++i) ss += f[i] * f[i];
#pragma unroll
            for (int off = 1; off < TPR; off <<= 1) ss += shx(ss, off, lane);
            const float rs = rsqrtf(ss * (1.0f / D) + EPS);
#pragma unroll
            for (int i = 0; i < 8; ++i) f[i] *= rs * kg[cc * 8 + i];
            u.x = cvt_pk_bf16(f[0], f[1]); u.y = cvt_pk_bf16(f[2], f[3]); u.z = cvt_pk_bf16(f[4], f[5]); u.w = cvt_pk_bf16(f[6], f[7]);
          }
          *(uint4*)(Ks + (ps * RPP + trow) * KP + cc * 8) = u;
        }
#pragma unroll
      for (int ps = 0; ps < NPV; ++ps)
        if (ps * 2 * RPP < nk) {
          const int r = ps * 2 * RPP + 2 * trow;
          unsigned* vd = (unsigned*)(Vt + (cc * 8) * VP + (r ^ ((cc & 7) << 3)));
          const uint4 a = vreg[ps][0], b = vreg[ps][1];
          vd[0 * (VP / 2)] = (a.x & 0xffffu) | (b.x << 16); vd[1 * (VP / 2)] = (a.x >> 16) | (b.x & 0xffff0000u);
          vd[2 * (VP / 2)] = (a.y & 0xffffu) | (b.y << 16); vd[3 * (VP / 2)] = (a.y >> 16) | (b.y & 0xffff0000u);
          vd[4 * (VP / 2)] = (a.z & 0xffffu) | (b.z << 16); vd[5 * (VP / 2)] = (a.z >> 16) | (b.z & 0xffff0000u);
          vd[6 * (VP / 2)] = (a.w & 0xffffu) | (b.w << 16); vd[7 * (VP / 2)] = (a.w >> 16) | (b.w & 0xffff0000u);
        }
    }
    __syncthreads();
    }

    const int relbase = krow0 - qb * 128;
#pragma unroll 1
    for (int g = (nk >> 5) - 1; g >= 0; --g) {
      const int r0 = relbase + g * 32;
      bool masked = false;
      if (MODE == 1) {
        if (wdone) continue;
        if (r0 >= wid * 16 + 15) continue;
        masked = (r0 + 31 >= wid * 16);
      }
      if (MODE == 0) {
        if (r0 > wid * 16 + 15 || r0 + 31 <= wid * 16 - 128) continue;
      }
      f32x4 s[2];
#pragma unroll
      for (int sub = 0; sub < 2; ++sub) {
        s[sub] = f32x4{0.f, 0.f, 0.f, 0.f};
#pragma unroll
        for (int ks = 0; ks < NKS; ++ks) {
          bf16x8 a = *(const bf16x8*)(Ks + (g * 32 + sub * 16 + fr) * KP + ks * 32 + fq * 8);
          s[sub] = __builtin_amdgcn_mfma_f32_16x16x32_bf16(a, qf[ks], s[sub], 0, 0, 0);
        }
      }
      float w[8];
      if (MODE == 1) {
        float Lv[8], tot = 0.f; bool vld[8];
#pragma unroll
        for (int i = 0; i < 8; ++i) {
          const int rel = r0 + (i >> 2) * 16 + fq * 4 + (i & 3);
          vld[i] = !masked || (rel < qi);
          const float z2 = s[i >> 2][i & 3];
          const float lv = -(fmaxf(z2, 0.f) + flog2(1.0f + fexp2(-fabsf(z2))));
          Lv[i] = vld[i] ? lv : 0.f;
          tot += Lv[i];
        }
        tot = add_x32(add_x16(tot));
        union { unsigned u[4]; bf16x8 v; } hi, lo;
#pragma unroll
        for (int i = 0; i < 4; ++i) {
          const unsigned hp = cvt_pk_bf16(Lv[2 * i], Lv[2 * i + 1]);
          hi.u[i] = hp;
          lo.u[i] = cvt_pk_bf16(Lv[2 * i] - bflo(hp), Lv[2 * i + 1] - bfhi(hp));
        }
        f32x4 cs[2];
#pragma unroll
        for (int ss_ = 0; ss_ < 2; ++ss_) {
          cs[ss_] = f32x4{0.f, 0.f, 0.f, 0.f};
          cs[ss_] = __builtin_amdgcn_mfma_f32_16x16x32_bf16(uop[ss_], hi.v, cs[ss_], 0, 0, 0);
          cs[ss_] = __builtin_amdgcn_mfma_f32_16x16x32_bf16(uop[ss_], lo.v, cs[ss_], 0, 0, 0);
        }
#pragma unroll
        for (int i = 0; i < 8; ++i) {
          const float e = s[i >> 2][i & 3] + cs[i >> 2][i & 3] + R;
          w[i] = vld[i] ? fexp2(e) : 0.f;
        }
        R += tot;
        wdone = __all(R < -150.0f);
      } else {
        float gmax = -1e30f;
#pragma unroll
        for (int i = 0; i < 8; ++i) {
          bool v = true;
          if (MODE == 0) { const int rel = r0 + (i >> 2) * 16 + fq * 4 + (i & 3); v = (rel <= qi) && (rel > qi - 128); }
          w[i] = v ? s[i >> 2][i & 3] : -1e30f;
          gmax = fmaxf(gmax, w[i]);
        }
        gmax = max_x32(max_x16(gmax));
        const float m_new = fmaxf(m_run, gmax);
        const float alpha = fexp2(m_run - m_new);
        float ps = 0.f;
#pragma unroll
        for (int i = 0; i < 8; ++i) { w[i] = fexp2(w[i] - m_new); ps += w[i]; }
        lsum = lsum * alpha + ps;
#pragma unroll
        for (int d = 0; d < NDS; ++d) { o[d][0] *= alpha; o[d][1] *= alpha; o[d][2] *= alpha; o[d][3] *= alpha; }
        m_run = m_new;
      }
      union { unsigned u[4]; bf16x8 v; } wb;
#pragma unroll
      for (int i = 0; i < 4; ++i) wb.u[i] = cvt_pk_bf16(w[2 * i], w[2 * i + 1]);
#pragma unroll
      for (int d = 0; d < NDS; ++d) {
        const int sw = ((2 * d + (fr >> 3)) & 7) << 3;
        const bf16_t* vrow = Vt + (d * 16 + fr) * VP;
        union { uint2 h[2]; bf16x8 v; } a;
        a.h[0] = *(const uint2*)(vrow + ((g * 32 + 4 * fq) ^ sw)); a.h[1] = *(const uint2*)(vrow + ((g * 32 + 16 + 4 * fq) ^ sw));
        o[d] = __builtin_amdgcn_mfma_f32_16x16x32_bf16(a.v, wb.v, o[d], 0, 0, 0);
      }
    }
    if (MODE != 1) break;
    __syncthreads();
    if (lane == 0) flags[wid] = wdone ? 1 : 0;
    __syncthreads();
    int all = 1;
#pragma unroll
    for (int i = 0; i < 8; ++i) all &= flags[i];
    if (all || krow0 == 0) break;
    krow0 -= 128; nk = 128;
  }

  float inv = 1.0f;
  if (MODE != 1) {
    lsum = add_x32(add_x16(lsum));
    if (MODE == 0) lsum += fexp2(p->swa_sinks[l * 8 + h] * LOG2E - m_run);
    inv = 1.0f / lsum;
  }
#pragma unroll
  for (int d = 0; d < NDS; ++d) {
    const uint2 gv = gvp[d];
    uint2 pk;
    pk.x = cvt_pk_bf16(o[d][0] * inv * siluf_(bflo(gv.x)), o[d][1] * inv * siluf_(bfhi(gv.x)));
    pk.y = cvt_pk_bf16(o[d][2] * inv * siluf_(bflo(gv.y)), o[d][3] * inv * siluf_(bfhi(gv.y)));
    *(uint2*)(qptr + d * 16 + 4 * fq) = pk;
  }
  }
}

#undef ATTN_ISSUE_LOADS_

template <int APPLY>
__device__ void lru_item(PP p, int l, int bb, int ck, int nb, unsigned epoch) {
  bf16_t* cxs = (bf16_t*)smem;
  bf16_t* xcs = (bf16_t*)(smem + 16896);
  bf16_t* wta = (bf16_t*)(smem + 35328);
  bf16_t* wtx = (bf16_t*)(smem + 44544);
  float* as_ = (float*)(smem + 53760);
  float* bs_ = (float*)(smem + 86528);
  float* segA = (float*)(smem + 119296);
  float* segH = (float*)(smem + 121344);
  float* cin = (float*)(smem + 123392);
  const int tid = otid(), wid = tid >> 6, lane = tid & 63, fr = lane & 15, fq = lane >> 4;
  float* partA = (float*)(smem + 125440);
  float* partH = (float*)(smem + 127488);
  const long row0 = (long)bb * SEQ + ck * 128;
  __syncthreads();
  bf16_t cgv[16];
  if (APPLY) {
    const int ch = tid & 63, seg = tid >> 6;
#pragma unroll
    for (int i = 0; i < 16; ++i) cgv[i] = p->proj[(row0 + seg * 16 + i) * INW + C_CG + nb * 64 + ch];
  }
  if (APPLY == 1) {
    const int ch = tid & 63, w = tid >> 6;
    const int lo = (ck * w) >> 3, hi = (ck * (w + 1)) >> 3;
    const float* pa = p->lruA + (long)(bb * 64) * 512 + nb * 64 + ch;
    const float* ph = p->lruH + (long)(bb * 64) * 512 + nb * 64 + ch;
    float av[8], hv[8];
#pragma unroll
    for (int i = 0; i < 8; ++i) { const bool ok = lo + i < hi; av[i] = ok ? pa[(lo + i) * 512] : 1.0f; hv[i] = ok ? ph[(lo + i) * 512] : 0.0f; }
    float Ap = 1.f, Hp = 0.f;
#pragma unroll
    for (int i = 0; i < 8; ++i) { Hp = av[i] * Hp + hv[i]; Ap *= av[i]; }
    partA[w * 64 + ch] = Ap; partH[w * 64 + ch] = Hp;
  }
  for (int s = tid; s < 131 * 8; s += 512) {
    const int r = s >> 3, cc = s & 7, t = ck * 128 + r - 3;
    uint4 u = make_uint4(0, 0, 0, 0);
    if (t >= 0) u = *(const uint4*)(p->proj + ((long)bb * SEQ + t) * INW + C_CX + nb * 64 + cc * 8);
    *(uint4*)(cxs + r * 64 + cc * 8) = u;
  }
  {
    const bf16_t* wsrc = p->lruWT + (long)((l * 8 + nb) * 2) * 4096;
    const int d = tid >> 3, c8 = (tid & 7) * 8;
    *(uint4*)(wta + d * 72 + c8) = *(const uint4*)(wsrc + d * 64 + c8);
    *(uint4*)(wtx + d * 72 + c8) = *(const uint4*)(wsrc + 4096 + d * 64 + c8);
  }
  __syncthreads();
  {
    const int ch = tid & 63, gch = nb * 64 + ch;
    const float* cw = p->conv_w + (long)l * 4 * 512 + gch;
    const float w0 = cw[0], w1 = cw[512], w2 = cw[1024], w3 = cw[1536], cb = p->conv_b[l * 512 + gch];
#pragma unroll
    for (int i = 0; i < 16; ++i) {
      const int tok = (tid >> 6) + 8 * i;
      const float v = cb + w0 * bf2f(cxs[(tok + 0) * 64 + ch]) + w1 * bf2f(cxs[(tok + 1) * 64 + ch]) +
                      w2 * bf2f(cxs[(tok + 2) * 64 + ch]) + w3 * bf2f(cxs[(tok + 3) * 64 + ch]);
      xcs[tok * 72 + ch] = f2bf(v);
    }
  }
  __syncthreads();
  {
    bf16x8 a[2];
#pragma unroll
    for (int ks = 0; ks < 2; ++ks) a[ks] = *(const bf16x8*)(xcs + (wid * 16 + fr) * 72 + ks * 32 + fq * 8);
#pragma unroll
    for (int nk = 0; nk < 4; ++nk) {
      f32x4 ra = f32x4{0.f, 0.f, 0.f, 0.f}, ia = f32x4{0.f, 0.f, 0.f, 0.f};
#pragma unroll
      for (int ks = 0; ks < 2; ++ks) {
        bf16x8 ba = *(const bf16x8*)(wta + (nk * 16 + fr) * 72 + ks * 32 + fq * 8);
        bf16x8 bx = *(const bf16x8*)(wtx + (nk * 16 + fr) * 72 + ks * 32 + fq * 8);
        ra = __builtin_amdgcn_mfma_f32_16x16x32_bf16(a[ks], ba, ra, 0, 0, 0);
        ia = __builtin_amdgcn_mfma_f32_16x16x32_bf16(a[ks], bx, ia, 0, 0, 0);
      }
      const int ch = nk * 16 + fr, gch = nb * 64 + ch;
      const float ba_ = p->lru_b_a[l * 512 + gch], bx_ = p->lru_b_x[l * 512 + gch];
      const float sp = log1pf(__expf(-p->lru_lambda[l * 512 + gch]));
      const float* cw = p->conv_w + (long)l * 4 * 512 + gch;
      const float w0 = cw[0], w1 = cw[512], w2 = cw[1024], w3 = cw[1536], cb = p->conv_b[l * 512 + gch];
#pragma unroll
      for (int reg = 0; reg < 4; ++reg) {
        const int tok = wid * 16 + 4 * fq + reg;
        const float r = sigmoidf_(ra[reg] + ba_), ig = sigmoidf_(ia[reg] + bx_);
        const float log_a = -8.0f * r * sp;
        const float av = __expf(log_a);
        const float mult = sqrtf(fmaxf(1.0f - __expf(2.0f * log_a), 0.f));
        const float xc = cb + w0 * bf2f(cxs[(tok + 0) * 64 + ch]) + w1 * bf2f(cxs[(tok + 1) * 64 + ch]) +
                         w2 * bf2f(cxs[(tok + 2) * 64 + ch]) + w3 * bf2f(cxs[(tok + 3) * 64 + ch]);
        as_[tok * 64 + ch] = av;
        bs_[tok * 64 + ch] = mult * ig * xc;
      }
    }
  }
  __syncthreads();
  {
    const int ch = tid & 63, seg = tid >> 6;
    float P = 1.f, hh = 0.f;
#pragma unroll
    for (int i = 0; i < 16; ++i) {
      const int idx = (seg * 16 + i) * 64 + ch;
      const float a = as_[idx], b = bs_[idx];
      hh = a * hh + b; P *= a;
      as_[idx] = P; bs_[idx] = hh;
    }
    segA[seg * 64 + ch] = P; segH[seg * 64 + ch] = hh;
  }
  __syncthreads();
  if (APPLY == 2) {
    unsigned long long* tg = p->lruT + ((long)(bb * 64) * 512 + nb * 64) * 2;
    if (tid < 64) {
      const int ch = tid;
      float hl = 0.f, At = 1.f;
#pragma unroll
      for (int sg = 0; sg < 8; ++sg) { const float a = segA[sg * 64 + ch]; hl = a * hl + segH[sg * 64 + ch]; At *= a; }
      unsigned long long* dst = tg + ((long)ck * 512 + ch) * 2;
      __hip_atomic_store(dst, ((unsigned long long)epoch << 32) | __float_as_uint(At), __ATOMIC_RELAXED, __HIP_MEMORY_SCOPE_AGENT);
      __hip_atomic_store(dst + 1, ((unsigned long long)epoch << 32) | __float_as_uint(hl), __ATOMIC_RELAXED, __HIP_MEMORY_SCOPE_AGENT);
    }
    {
      const int ch = tid & 63, w = tid >> 6;
      const int lo = (ck * w) >> 3, hi = (ck * (w + 1)) >> 3;
      unsigned long long wa[8], wh[8];
      unsigned spins = 0;
      for (;;) {
        bool ok = true;
#pragma unroll
        for (int i = 0; i < 8; ++i) {
          if (lo + i < hi) {
            const unsigned long long* src = tg + ((long)(lo + i) * 512 + ch) * 2;
            wa[i] = __hip_atomic_load(src, __ATOMIC_RELAXED, __HIP_MEMORY_SCOPE_AGENT);
            wh[i] = __hip_atomic_load(src + 1, __ATOMIC_RELAXED, __HIP_MEMORY_SCOPE_AGENT);
            ok = ok && ((unsigned)(wa[i] >> 32) == epoch) && ((unsigned)(wh[i] >> 32) == epoch);
          }
        }
        if (ok || ++spins > (1u << 20)) break;
        __builtin_amdgcn_s_sleep(2);
      }
      float Ap = 1.f, Hp = 0.f;
#pragma unroll
      for (int i = 0; i < 8; ++i)
        if (lo + i < hi) { const float a = __uint_as_float((unsigned)wa[i]), hvv = __uint_as_float((unsigned)wh[i]); Hp = a * Hp + hvv; Ap *= a; }
      partA[w * 64 + ch] = Ap; partH[w * 64 + ch] = Hp;
    }
    __syncthreads();
  }
  if (tid < 64) {
    const int ch = tid;
    float carry = 0.f;
    if (APPLY) {
#pragma unroll
      for (int w = 0; w < 8; ++w) carry = partA[w * 64 + ch] * carry + partH[w * 64 + ch];
    }
    float At = 1.f;
#pragma unroll
    for (int sg = 0; sg < 8; ++sg) {
      cin[sg * 64 + ch] = carry;
      const float a = segA[sg * 64 + ch];
      carry = a * carry + segH[sg * 64 + ch]; At *= a;
    }
    if (!APPLY) {
      p->lruA[(long)(bb * 64 + ck) * 512 + nb * 64 + ch] = At;
      p->lruH[(long)(bb * 64 + ck) * 512 + nb * 64 + ch] = carry;
    }
  }
  if (APPLY) {
    __syncthreads();
    const int ch = tid & 63, seg = tid >> 6;
    const float c0 = cin[seg * 64 + ch];
#pragma unroll
    for (int i = 0; i < 16; ++i) {
      const int tok = seg * 16 + i, idx = tok * 64 + ch;
      const float hv = bs_[idx] + as_[idx] * c0;
      bf16_t* gp = p->proj + (row0 + tok) * INW + C_CG + nb * 64 + ch;
      *gp = f2bf(hv * siluf_(bf2f(cgv[i])));
    }
  }
}

__device__ void phase_mix(PP p, int c, int l) {
  constexpr int N_SWA = CB * 64 * 2, N_MEM = CB * 32 * 4, N_SB = CB * 64 * 8, N_LRU = CB * 64 * 8;
  const unsigned epoch = (unsigned)(c * 2 + l) + 1u;
  for (int i = blockIdx.x; i < N_SWA + N_MEM + N_SB + N_LRU; i += gridDim.x) {
    if (i < N_SWA) { const int kvh = i & 1, qb = (i >> 1) & 63, bb = i >> 7; attn_item<64, 0>(p, c, l, bb, qb, kvh * 4); }
    else if (i < N_SWA + N_MEM) { const int j = i - N_SWA, h = j & 3, qg = (j >> 2) & 31, bb = j >> 7; attn_item<128, 2>(p, c, l, bb, qg * 2, h); }
    else if (i < N_SWA + N_MEM + N_SB) { const int j = i - N_SWA - N_MEM, h = j & 7, qb = (j >> 3) & 63, bb = j >> 9; attn_item<64, 1>(p, c, l, bb, qb, h); }
    else { const int j = i - N_SWA - N_MEM - N_SB, nb = j & 7, ck = (j >> 3) & 63, bb = j >> 9; lru_item<2>(p, l, bb, ck, nb, epoch); }
  }
}

#define XB_TMO      128
#define XB_XCNT(j)  (256  + 64 * (j))
#define XB_XSUB(j)  (1280 + 64 * (j))
#define XB_XGEN(j)  (2304 + 64 * (j))
#define XB_TOP      3328
#define XB_TOPGEN   3392
#define XCD_BAR_WORDS 3456
#define XB_SPIN_CAP (1u << 18)
#define LAS __attribute__((address_space(3)))

__device__ __forceinline__ unsigned xb_ld(unsigned* p)              { return __hip_atomic_load(p, __ATOMIC_RELAXED, __HIP_MEMORY_SCOPE_AGENT); }
__device__ __forceinline__ unsigned xb_add(unsigned* p, unsigned v) { return __hip_atomic_fetch_add(p, v, __ATOMIC_RELAXED, __HIP_MEMORY_SCOPE_AGENT); }
__device__ __forceinline__ unsigned xb_xcc_id() { return (unsigned)__builtin_amdgcn_s_getreg((3 << 11) | 20) & 0xFu; }
#define XB_SPIN(cond, bar) do { unsigned _sp = 0; while (cond) { __builtin_amdgcn_s_sleep(1); \
    if ((++_sp & 255u) == 0u) { if (xb_ld(&(bar)[XB_TMO])) break; if (_sp > XB_SPIN_CAP) { atomicAdd(&(bar)[XB_TMO], 1u); break; } } } } while (0)

struct XcdBarrier {
    unsigned* bar; unsigned x;
    volatile LAS unsigned* st;
};

__device__ __forceinline__ XcdBarrier xcd_barrier_post(unsigned* bar, volatile LAS unsigned* st) {
    XcdBarrier b; b.bar = bar; b.x = xb_xcc_id(); b.st = st;
    if (otid() == 0) (void)xb_add(&bar[XB_XCNT(b.x)], 1u);
    return b;
}
__device__ __forceinline__ void xcd_barrier_complete(unsigned* bar, unsigned x, unsigned& nloc, unsigned& nx) {
    const unsigned G = gridDim.x * gridDim.y * gridDim.z;
    unsigned sum, cnt, mine, sp = 0u;
    for (;;) {
        sum = 0u; cnt = 0u; mine = 0u;
#pragma unroll
        for (unsigned j = 0; j < 16; ++j) { const unsigned c = xb_ld(&bar[XB_XCNT(j)]); sum += c; cnt += (c > 0u) ? 1u : 0u; mine = (j == x) ? c : mine; }
        if (sum == G) break;
        __builtin_amdgcn_s_sleep(1);
        if ((++sp & 255u) == 0u) { if (xb_ld(&bar[XB_TMO])) break; if (sp > XB_SPIN_CAP) { atomicAdd(&bar[XB_TMO], 1u); break; } }
    }
    nloc = mine > 0u ? mine : 1u; nx = cnt > 0u ? cnt : 1u;
}

__device__ __forceinline__ void xcd_barrier(const XcdBarrier& b) {
    asm volatile("s_waitcnt vmcnt(0)" ::: "memory");
    __syncthreads();
    if (otid() == 0) {
        unsigned* bar = b.bar;
        __builtin_amdgcn_s_waitcnt(0);
        unsigned nloc = b.st[0], nx = b.st[1];
        if (nloc == 0u) { xcd_barrier_complete(bar, b.x, nloc, nx); b.st[0] = nloc; b.st[1] = nx; }
        const unsigned old = xb_add(&bar[XB_XSUB(b.x)], 1u);
        const unsigned gen = old / nloc;
        if (old + 1u == (gen + 1u) * nloc) {
            __builtin_amdgcn_fence(__ATOMIC_RELEASE, "agent");
            asm volatile("s_waitcnt vmcnt(0)" ::: "memory");
            const unsigned og = xb_add(&bar[XB_TOP], 1u);
            const unsigned tg = og / nx;
            if (og + 1u == (tg + 1u) * nx) xb_add(&bar[XB_TOPGEN], 1u);
            else XB_SPIN(xb_ld(&bar[XB_TOPGEN]) == tg, bar);
            __builtin_amdgcn_fence(__ATOMIC_ACQUIRE, "agent");
            xb_add(&bar[XB_XGEN(b.x)], 1u);
            asm volatile("s_waitcnt vmcnt(0)" ::: "memory");
        } else {
            XB_SPIN(xb_ld(&bar[XB_XGEN(b.x)]) == gen, bar);
            __builtin_amdgcn_fence(__ATOMIC_ACQUIRE, "agent");
            asm volatile("s_waitcnt vmcnt(0)" ::: "memory");
        }
    }
    __syncthreads();
}

constexpr int NPHASE = 1 + NCHUNK * 2 * 4;
__global__ void __launch_bounds__(512) mega(Params p_arg, int ph_lo, int ph_hi) {
  cg::grid_group grid = cg::this_grid();
  unsigned* p_bar = ((PP)__builtin_amdgcn_kernarg_segment_ptr())->bar;
  volatile LAS unsigned* bst = (volatile LAS unsigned*)(smem + LDS_BYTES - 16);
  if (threadIdx.x < 4) bst[threadIdx.x] = 0u;
  if ((threadIdx.x & 63) == 0) *(volatile LAS int*)((LAS char*)smem + WIDTAB_OFF + hw_wave_slot() * 4) = (int)(threadIdx.x >> 6);
  __syncthreads();
  const XcdBarrier xbar = xcd_barrier_post(p_bar, bst);
#pragma unroll 1
  for (int ph = ph_lo; ph < ph_hi; ++ph) {
    if (ph > ph_lo) {
      if (ph_hi > 4096) grid.sync();
      xcd_barrier(xbar);
    }
    PP p = (PP)__builtin_amdgcn_kernarg_segment_ptr();
    asm volatile("" : "+s"(p));
    if (ph == 0) {
      int nrep = (PROBE == 6) ? 2 : 1; asm volatile("" : "+s"(nrep));
#pragma unroll 1
      for (int r = 0; r < nrep; ++r) { phase_prep(p); if (r + 1 < nrep) __syncthreads(); }
      continue;
    }
    const int q = ph - 1, kind = q & 3, cl = q >> 2, c = cl >> 1, l = cl & 1;
    const int nsub = ((PROBE == 1 || PROBE == 4 || PROBE == 5) && kind == 0) ? 2 : 1;
#pragma unroll 1
    for (int s = 0; s < nsub; ++s) {
      int kk = (s == nsub - 1) ? kind : ((PROBE == 4) ? 2 : 0);
      asm volatile("" : "+s"(kk));
      if (kk == 0) phase_g1(p, c, l, (PROBE == 5 && s < nsub - 1) ? 1 : 0);
      else if (kk == 1) phase_mix(p, c, l);
      else if (kk == 2) phase_g2(p, c, l);
      else phase_g3(p, c, l);
      if (s < nsub - 1) __syncthreads();
    }
  }
}

extern "C" void kernel_launch(void* const* d_in, const int* in_sizes, int n_in, void* d_out, int out_size, void* d_ws,
                              size_t ws_size, hipStream_t stream) {
  static int grid_blocks = 0;
  if (!grid_blocks) {
    int dev = 0, cus = 0, per_cu = 0;
    hipGetDevice(&dev);
    hipDeviceGetAttribute(&cus, hipDeviceAttributeMultiprocessorCount, dev);
    hipFuncSetAttribute((const void*)mega, hipFuncAttributeMaxDynamicSharedMemorySize, LDS_BYTES);
    hipOccupancyMaxActiveBlocksPerMultiprocessor(&per_cu, (const void*)mega, 512, LDS_BYTES);
    if (per_cu < 1) per_cu = 1;
    grid_blocks = cus * 1;
    (void)hipGetLastError();
  }
  Params p{};
  const float* const* in = (const float* const*)d_in;
  p.x = in[0]; p.mem = in[1]; p.norm_gain = in[2]; p.w_in = in[3]; p.swa_q_gain = in[4]; p.swa_k_gain = in[5];
  p.swa_sinks = in[6]; p.conv_w = in[7]; p.conv_b = in[8]; p.lru_w_a = in[9]; p.lru_b_a = in[10]; p.lru_w_x = in[11];
  p.lru_b_x = in[12]; p.lru_lambda = in[13]; p.mem_norm_gain = in[14]; p.w_mem_kv = in[15]; p.mem_q_gain = in[16];
  p.mem_k_gain = in[17]; p.w_branch = in[18]; p.w_out = in[19];
  p.out = (float*)d_out;
  char* ws = (char*)d_ws; size_t off = 0;
  auto take = [&](size_t bytes) { char* r = ws + off; off += (bytes + 255) & ~(size_t)255; return r; };
  p.bar = (unsigned*)take(XCD_BAR_WORDS * 4);
  p.lruT = (unsigned long long*)take((size_t)CB * 64 * 512 * 2 * 8);
  p.WinT = (bf16_t*)take((size_t)2 * INW * DM * 2);
  p.WbrT = (bf16_t*)take((size_t)8 * DM * 512 * 2);
  p.WoutT = (bf16_t*)take((size_t)2 * DM * DM * 2);
  p.WmkvT = (bf16_t*)take((size_t)2 * DM * DM * 2);
  p.xb = (bf16_t*)take((size_t)NTOK * DM * 2);
  p.memb = (bf16_t*)take((size_t)BATCH * 256 * DM * 2);
  p.mkv = (bf16_t*)take((size_t)2 * BATCH * 256 * DM * 2);
  p.ssq_x = (float*)take((size_t)2 * NTOK * 4);
  p.ssq_mem = (float*)take((size_t)BATCH * 256 * 4);
  p.lruA = (float*)take((size_t)CB * 64 * 512 * 4);
  p.lruH = (float*)take((size_t)CB * 64 * 512 * 4);
  p.lruWT = (bf16_t*)take((size_t)32 * 4096 * 2);
  p.xb8 = (unsigned char*)take((size_t)NTOK * DM);
  p.Wg8 = (unsigned char*)take((size_t)2 * 4096 * DM);
  p.proj = (bf16_t*)take((size_t)CT * INW * 2);
  if (off > ws_size) { fprintf(stderr, "kernel_launch: workspace too small: need %zu have %zu\n", off, ws_size); return; }
  (void)hipMemsetAsync(p.bar, 0, (size_t)((char*)p.lruT - (char*)p.bar) + (size_t)CB * 64 * 512 * 2 * 8, stream);
#if COOP
  int lo = 0, hi = NPHASE;
  void* args[] = {&p, &lo, &hi};
  hipError_t e = hipLaunchCooperativeKernel((const void*)mega, dim3(grid_blocks), dim3(512), args, LDS_BYTES, stream);
  if (e != hipSuccess) fprintf(stderr, "cooperative launch failed: %s (grid %d)\n", hipGetErrorString(e), grid_blocks);
#else
  for (int ph = 0; ph < NPHASE; ++ph) mega<<<grid_blocks, 512, LDS_BYTES, stream>>>(p, ph, ph + 1);
#endif
}
```

```cpp
#include <hip/hip_runtime.h>
#include <hip/hip_cooperative_groups.h>
#include <cstdint>
#include <cstdio>
namespace cg = cooperative_groups;

#ifndef PM
#define PM 63
#endif
#ifndef PROBE
#define PROBE 0
#endif
#ifndef COOP
#define COOP 1
#endif

typedef unsigned short bf16_t;
typedef short bf16x8 __attribute__((ext_vector_type(8)));
typedef float f32x4 __attribute__((ext_vector_type(4)));

constexpr int DM = 1024, BATCH = 4, SEQ = 8192, NTOK = BATCH * SEQ, INW = 9472;
constexpr int CB = 2, CT = CB * SEQ, NCHUNK = BATCH / CB;
constexpr int C_AQ = 0, C_AK = 512, C_AV = 640, C_AG = 768, C_BQ = 1280, C_BK = 1792, C_BV = 2304, C_BG = 2816,
              C_CX = 3328, C_CG = 3840, C_MQ = 4352, C_MG = 4864, C_MRG = 5376,
              C_MIX = 7424;
constexpr int LDS_BYTES = 139264;
constexpr float EPS = 1e-6f;
constexpr float LOG2E = 1.4426950408889634f;

struct Params {
  const float *x, *mem, *norm_gain, *w_in, *swa_q_gain, *swa_k_gain, *swa_sinks, *conv_w, *conv_b,
      *lru_w_a, *lru_b_a, *lru_w_x, *lru_b_x, *lru_lambda, *mem_norm_gain, *w_mem_kv,
      *mem_q_gain, *mem_k_gain, *w_branch, *w_out;
  float* out;
  bf16_t *WinT, *WbrT, *WoutT, *WmkvT, *xb, *memb, *mkv, *proj;
  float *ssq_x, *ssq_mem, *lruA, *lruH;
  unsigned* bar;
  bf16_t* lruWT;
  unsigned long long* lruT;
  unsigned char *xb8, *Wg8;
};

typedef const __attribute__((address_space(4))) Params* PP;
extern __shared__ __attribute__((aligned(16))) char smem[];
constexpr int WIDTAB_OFF = 138240;
__device__ __forceinline__ int hw_wave_slot() { return (int)(__builtin_amdgcn_s_getreg((5 << 11) | 4) & 63u); }
__device__ __forceinline__ int otid() {
  const int wid = *(volatile __attribute__((address_space(3))) int*)((__attribute__((address_space(3))) char*)smem + WIDTAB_OFF + hw_wave_slot() * 4);
  unsigned ones = ~0u; asm volatile("" : "+s"(ones));
  int t = wid * 64 + (int)__builtin_amdgcn_mbcnt_hi(ones, __builtin_amdgcn_mbcnt_lo(ones, 0u));
  asm volatile("" : "+v"(t)); return t;
}

typedef __bf16 bf16v2 __attribute__((ext_vector_type(2)));
typedef float f32v2 __attribute__((ext_vector_type(2)));
__device__ __forceinline__ unsigned cvt_pk_bf16(float lo, float hi) {
  f32v2 v = {lo, hi};
  return __builtin_bit_cast(unsigned, __builtin_convertvector(v, bf16v2));
}
__device__ __forceinline__ bf16_t f2bf(float f) { return (bf16_t)(cvt_pk_bf16(f, 0.f) & 0xffffu); }
__device__ __forceinline__ float bf2f(bf16_t b) { return __uint_as_float(((unsigned)b) << 16); }
__device__ __forceinline__ float bflo(unsigned w) { return __uint_as_float(w << 16); }
__device__ __forceinline__ float bfhi(unsigned w) { return __uint_as_float(w & 0xffff0000u); }
__device__ __forceinline__ float fexp2(float x) { return __builtin_amdgcn_exp2f(x); }
__device__ __forceinline__ float flog2(float x) { return __builtin_amdgcn_logf(x); }
__device__ __forceinline__ float frcp(float x) { return __builtin_amdgcn_rcpf(x); }
__device__ __forceinline__ float sigmoidf_(float x) { return frcp(1.0f + fexp2(-x * LOG2E)); }
__device__ __forceinline__ float siluf_(float x) { return x * sigmoidf_(x); }
__device__ __forceinline__ float shx(float v, int mask, int lane) { return __int_as_float(__builtin_amdgcn_ds_bpermute((lane ^ mask) << 2, __float_as_int(v))); }

__device__ __forceinline__ int lds_byte(int r, int c) {
  int st = (r >> 4) * 2 + (c >> 5), rr = r & 15, cc = c & 31, ob = rr * 64 + cc * 2;
  return st * 1024 + (ob ^ (((ob >> 9) & 1) << 5));
}
__device__ __forceinline__ void stage_rc(int b, int& R, int& C) {
  int st = b / 1024, sb = b % 1024, swz = sb ^ (((sb >> 9) & 1) << 5);
  R = (st >> 1) * 16 + swz / 64; C = (st & 1) * 32 + (swz % 64) / 2;
}

#define WAIT_VN(N) asm volatile("s_waitcnt vmcnt(%0)" ::"n"(N) : "memory")
#define WAIT_L(n) asm volatile("s_waitcnt lgkmcnt(" #n ")" ::: "memory")
#define BAR __builtin_amdgcn_s_barrier()
#define SCHED __builtin_amdgcn_sched_barrier(0)

struct GUnit { const bf16_t* A; const bf16_t* B; };

template <int AM, bool FP8, class PH>
__device__ __forceinline__ void gemm_stream(PH& ph, const int nu, const int lda, const int ldb, const int K) {
  constexpr int LA = AM / 2, HA = 32 * AM;
  constexpr int W1 = 2 + LA, W2 = 4 + LA, W3 = LA;
  if (nu <= 0) return;
  const int tid = otid(), wid = tid >> 6, lane = tid & 63, wr = wid >> 2, wc = wid & 3, fr = lane & 15, fq = lane >> 4;
  unsigned aoff0, boff0;
  { int r, c; stage_rc(tid * 16, r, c); aoff0 = (unsigned)(r * lda + c) * 2u;
    const int rho = r & 31, pr = (r & ~31) + 8 * ((rho & 15) >> 2) + 4 * (rho >> 4) + (rho & 3);
    boff0 = (unsigned)(pr * ldb + c) * 2u; }
  const long a64 = (long)64 * lda, b64 = (long)64 * ldb;
  const long a1o = (long)HA * lda, b1o = (long)128 * ldb;
  int one_e8m0 = 127; asm volatile("" : "+s"(one_e8m0));
  const int ldsw = __builtin_amdgcn_readfirstlane(wid) * 1024;
#define SA_(b, h) (smem + ((b) * 2 + (h)) * 16384)
#define SB_(b, h) (smem + (4 + (b) * 2 + (h)) * 16384)
#define STG_A(b, h, base) do { _Pragma("unroll") for (int _i = 0; _i < LA; ++_i) \
    __builtin_amdgcn_global_load_lds((const unsigned*)((const char*)((base) + ((h) ? a1o : 0) + _i * a64) + aoff0), (unsigned*)(SA_(b, h) + ldsw + _i * 8192), 16, 0, 0); } while (0)
#define STG_B(b, h, base) do { _Pragma("unroll") for (int _i = 0; _i < 2; ++_i) \
    __builtin_amdgcn_global_load_lds((const unsigned*)((const char*)((base) + ((h) ? b1o : 0) + _i * b64) + boff0), (unsigned*)(SB_(b, h) + ldsw + _i * 8192), 16, 0, 0); } while (0)
  typedef int v4i_t __attribute__((ext_vector_type(4)));
  typedef int v8i_t __attribute__((ext_vector_type(8)));
  const int tsw = lds_byte(fr, fq * 8);
  const char* abase = smem + wr * (AM * 2048) + tsw;
  const char* bbase = smem + 65536 + wc * 4096 + tsw;
#define LDA_(dst, b, h) do { if (FP8) { _Pragma("unroll") for (int m = 0; m < AM; ++m) { \
      const v4i_t lo_ = *reinterpret_cast<const v4i_t*>(abase + (((b) * 2 + (h)) * 16384 + m * 2048)); \
      const v4i_t hi_ = *reinterpret_cast<const v4i_t*>(abase + (((b) * 2 + (h)) * 16384 + m * 2048 + 1024)); \
      dst##8[m] = __builtin_shufflevector(lo_, hi_, 0, 1, 2, 3, 4, 5, 6, 7); } \
    } else { _Pragma("unroll") for (int m = 0; m < AM; ++m) _Pragma("unroll") for (int k = 0; k < 2; ++k) \
    dst[m][k] = *reinterpret_cast<const bf16x8*>(abase + (((b) * 2 + (h)) * 16384 + m * 2048 + k * 1024)); } } while (0)
#define LDB_(dst, b, h) do { if (FP8) { _Pragma("unroll") for (int n = 0; n < 2; ++n) { \
      const v4i_t lo_ = *reinterpret_cast<const v4i_t*>(bbase + (((b) * 2 + (h)) * 16384 + n * 2048)); \
      const v4i_t hi_ = *reinterpret_cast<const v4i_t*>(bbase + (((b) * 2 + (h)) * 16384 + n * 2048 + 1024)); \
      dst##8[n] = __builtin_shufflevector(lo_, hi_, 0, 1, 2, 3, 4, 5, 6, 7); } \
    } else { _Pragma("unroll") for (int n = 0; n < 2; ++n) _Pragma("unroll") for (int k = 0; k < 2; ++k) \
    dst[n][k] = *reinterpret_cast<const bf16x8*>(bbase + (((b) * 2 + (h)) * 16384 + n * 2048 + k * 1024)); } } while (0)
#define MMA_(ai, bj, At, Bx) do { __builtin_amdgcn_s_setprio(1); \
    if (FP8) { \
      _Pragma("unroll") for (int m = 0; m < AM; ++m) _Pragma("unroll") for (int n = 0; n < 2; ++n) \
        acc[ai][bj][m][n] = __builtin_amdgcn_mfma_scale_f32_16x16x128_f8f6f4(Bx##8[n], At##8[m], acc[ai][bj][m][n], 0, 0, 0, one_e8m0, 0, one_e8m0); \
    } else { \
    _Pragma("unroll") for (int m = 0; m < AM; ++m) _Pragma("unroll") for (int n = 0; n < 2; ++n) _Pragma("unroll") for (int k = 0; k < 2; ++k) \
      acc[ai][bj][m][n] = __builtin_amdgcn_mfma_f32_16x16x32_bf16(Bx[n][k], At[m][k], acc[ai][bj][m][n], 0, 0, 0); \
    } \
    __builtin_amdgcn_s_setprio(0); } while (0)

  f32x4 acc[2][2][AM][2];
  bf16x8 At[AM][2], Bf0[2][2], Bf1[2][2];
  v8i_t At8[AM], Bf08[2], Bf18[2];
  const int nt = K / 64;
  GUnit cur = ph.unit(0);
  constexpr int WS = 4 + 2 * LA, WP0 = LA, WP1 = 4 + LA;
  STG_B(0, 0, cur.B); STG_B(0, 1, cur.B); STG_A(0, 0, cur.A); STG_A(0, 1, cur.A);
  if (wr == 1) BAR;
  WAIT_VN(WP0); BAR;
  STG_B(1, 0, cur.B + 64); STG_A(1, 0, cur.A + 64); STG_B(1, 1, cur.B + 64);
  WAIT_VN(WP1); BAR;
#pragma unroll 1
  for (int u = 0; u < nu; ++u) {
#pragma unroll
    for (int a = 0; a < 2; ++a)
#pragma unroll
      for (int b = 0; b < 2; ++b)
#pragma unroll
        for (int m = 0; m < AM; ++m)
#pragma unroll
          for (int n = 0; n < 2; ++n) acc[a][b][m][n] = f32x4{0.f, 0.f, 0.f, 0.f};
    if (u > 0) { if (wr == 1) BAR; }
    const bool has_next = (u + 1 < nu);
    GUnit nx = cur;
    if (has_next) nx = ph.unit(u + 1);
#pragma unroll 1
    for (int t = 0; t < nt; t += 2) {
      const bool lastp = (t == nt - 2);
      if (lastp) ph.preload(u);
      const bf16_t* pa2 = lastp ? nx.A : cur.A + (t + 2) * 64;
      const bf16_t* pb2 = lastp ? nx.B : cur.B + (t + 2) * 64;
      const bf16_t* pa1 = cur.A + (t + 1) * 64;
      LDB_(Bf0, 0, 0); LDB_(Bf1, 0, 1); SCHED; LDA_(At, 0, 0); STG_A(1, 1, pa1);
      WAIT_VN(WS); WAIT_L(0); BAR; MMA_(0, 0, At, Bf0); MMA_(0, 1, At, Bf1); BAR; SCHED;
      LDA_(At, 0, 1); STG_B(0, 0, pb2); STG_B(0, 1, pb2); STG_A(0, 0, pa2);
      WAIT_VN(WS); WAIT_L(0); BAR; MMA_(1, 0, At, Bf0); MMA_(1, 1, At, Bf1); BAR; SCHED;
      LDB_(Bf0, 1, 0); LDB_(Bf1, 1, 1); SCHED; LDA_(At, 1, 0); STG_A(0, 1, pa2);
      WAIT_VN(WS); WAIT_L(0); BAR; MMA_(0, 0, At, Bf0); MMA_(0, 1, At, Bf1); BAR; SCHED;
      LDA_(At, 1, 1); STG_B(1, 0, pb2 + 64); STG_B(1, 1, pb2 + 64); STG_A(1, 0, pa2 + 64);
      WAIT_VN(WS); WAIT_L(0); BAR; MMA_(1, 0, At, Bf0); MMA_(1, 1, At, Bf1); BAR; SCHED;
    }
    if (wr == 0) BAR;
    ph.epilogue(u, acc);
    cur = nx;
  }
  WAIT_VN(0);
  BAR;
}

__device__ __forceinline__ void tile_remap(int L, int nM, int nN, int& pm, int& pn) {
  const int nwg = nM * nN; int wgid = L;
  const int q = nwg / 8, r = nwg % 8, xcd = wgid % 8, off = wgid / 8;
  wgid = (xcd < r ? xcd * (q + 1) : r * (q + 1) + (xcd - r) * q) + off;
  const int nig = 8 * nN, gid = wgid / nig, fm = gid * 8, gsz = min(nM - fm, 8);
  pm = fm + ((wgid % nig) % gsz); pn = (wgid % nig) / gsz;
}

struct TDesc { const float* src; bf16_t* dst; unsigned char* dst8; const float* scale; float mul; int N, K, k0, n0; };
__device__ __forceinline__ TDesc prep_desc(PP p, int u) {
  constexpr int U_IN = 16 * 84, U_BR = 8 * 16, U_SQ = 16 * 16, U_G8 = 16 * 64;
  TDesc t; t.dst8 = nullptr; t.mul = 1.0f;
  if (u < 2 * U_IN) {
    const int l = u / U_IN, v = u % U_IN;
    t.src = p->w_in + (long)l * DM * INW; t.N = INW; t.dst = p->WinT + (long)l * INW * DM; t.K = DM; t.k0 = (v / 84) * 64; t.n0 = (v % 84) * 64; t.scale = p->norm_gain + l * DM;
  } else if (u < 2 * U_IN + 8 * U_BR) {
    const int v = u - 2 * U_IN, ln = v / U_BR, w = v % U_BR;
    t.src = p->w_branch + (long)ln * 512 * DM; t.N = DM; t.dst = p->WbrT + (long)ln * DM * 512; t.K = 512; t.k0 = (w / 16) * 64; t.n0 = (w % 16) * 64; t.scale = nullptr;
  } else if (u < 2 * U_IN + 8 * U_BR + 2 * U_SQ) {
    const int v = u - (2 * U_IN + 8 * U_BR), l = v / U_SQ, w = v % U_SQ;
    t.src = p->w_out + (long)l * DM * DM; t.N = DM; t.dst = p->WoutT + (long)l * DM * DM; t.K = DM; t.k0 = (w / 16) * 64; t.n0 = (w % 16) * 64; t.scale = nullptr;
  } else if (u < 2 * U_IN + 8 * U_BR + 4 * U_SQ) {
    const int v = u - (2 * U_IN + 8 * U_BR + 2 * U_SQ), l = v / U_SQ, w = v % U_SQ;
    t.src = p->w_mem_kv + (long)l * DM * DM; t.N = DM; t.dst = p->WmkvT + (long)l * DM * DM; t.K = DM; t.k0 = (w / 16) * 64; t.n0 = (w % 16) * 64; t.scale = p->mem_norm_gain + l * DM;
  } else if (u < 2 * U_IN + 8 * U_BR + 4 * U_SQ + 2 * U_G8) {
    const int v = u - (2 * U_IN + 8 * U_BR + 4 * U_SQ), l = v / U_G8, w = v % U_G8;
    t.src = p->w_in + (long)l * DM * INW + C_MRG; t.N = INW; t.dst = nullptr; t.dst8 = p->Wg8 + (long)l * 4096 * DM; t.K = DM; t.k0 = (w / 64) * 64; t.n0 = (w % 64) * 64;
    t.scale = p->norm_gain + l * DM; t.mul = 32.0f;
  } else {
    const int v = u - (2 * U_IN + 8 * U_BR + 4 * U_SQ + 2 * U_G8), which = v & 1, lnb = v >> 1;
    t.src = (which ? p->lru_w_x : p->lru_w_a) + (long)lnb * 4096; t.N = 64; t.dst = p->lruWT + (long)v * 4096; t.K = 64; t.k0 = 0; t.n0 = 0; t.scale = nullptr;
  }
  return t;
}

__device__ void phase_prep(PP p) {
  const int tid = otid(), wid = tid >> 6, lane = tid & 63;
  constexpr int NU = 2 * 16 * 84 + 8 * 8 * 16 + 4 * 16 * 16 + 2 * 16 * 64 + 32, TB = 8;
  const int upw = (NU + (int)gridDim.x - 1) / (int)gridDim.x;
  const int ubeg = min((int)blockIdx.x * upw, NU), uend = min(ubeg + upw, NU);
  for (int base = ubeg; base < uend; base += TB) {
    __syncthreads();
#pragma unroll
    for (int j = 0; j < TB; ++j) {
      if (base + j < uend) {
        const TDesc t = prep_desc(p, base + j);
        float* tile = (float*)smem + j * (64 * 65);
#pragma unroll
        for (int e = tid; e < 1024; e += 512) {
          const int kk = e >> 4, n4 = (e & 15) * 4;
          float4 v = *(const float4*)(t.src + (long)(t.k0 + kk) * t.N + t.n0 + n4);
          if (t.scale) { const float sc = t.scale[t.k0 + kk] * t.mul; v.x *= sc; v.y *= sc; v.z *= sc; v.w *= sc; }
          float* d = tile + kk * 65 + n4;
          d[0] = v.x; d[1] = v.y; d[2] = v.z; d[3] = v.w;
        }
      }
    }
    __syncthreads();
#pragma unroll
    for (int j = 0; j < TB; ++j) {
      if (base + j < uend) {
        const TDesc t = prep_desc(p, base + j);
        const float* tile = (const float*)smem + j * (64 * 65);
        if (t.dst8) {
#pragma unroll
          for (int e = tid; e < 1024; e += 512) {
            const int nn = e >> 4, kk = (e & 15) * 4;
            unsigned w8 = 0;
            w8 = __builtin_amdgcn_cvt_pk_fp8_f32(tile[kk * 65 + nn], tile[(kk + 1) * 65 + nn], w8, false);
            w8 = __builtin_amdgcn_cvt_pk_fp8_f32(tile[(kk + 2) * 65 + nn], tile[(kk + 3) * 65 + nn], w8, true);
            *(unsigned*)(t.dst8 + (long)(t.n0 + nn) * t.K + t.k0 + kk) = w8;
          }
        } else {
#pragma unroll
        for (int e = tid; e < 2048; e += 512) {
          const int nn = e >> 5, kk = (e & 31) * 2;
          *(unsigned*)(t.dst + (long)(t.n0 + nn) * t.K + t.k0 + kk) = cvt_pk_bf16(tile[kk * 65 + nn], tile[(kk + 1) * 65 + nn]);
        }
        }
      }
    }
  }
  for (int r0 = (blockIdx.x * 8 + wid) * 2; r0 < NTOK + BATCH * 256; r0 += gridDim.x * 16) {
    const float* src[2]; bf16_t* dst[2]; float* sq[2]; float4 v[2][4];
#pragma unroll
    for (int q = 0; q < 2; ++q) {
      const int r = r0 + q;
      if (r < NTOK) { src[q] = p->x + (long)r * DM; dst[q] = p->xb + (long)r * DM; sq[q] = p->ssq_x + r; }
      else { const int m = r - NTOK; src[q] = p->mem + (long)m * DM; dst[q] = p->memb + (long)m * DM; sq[q] = p->ssq_mem + m; }
#pragma unroll
      for (int i = 0; i < 4; ++i) v[q][i] = *(const float4*)(src[q] + (i * 64 + lane) * 4);
    }
#pragma unroll
    for (int q = 0; q < 2; ++q) {
      float ss = 0.f;
#pragma unroll
      for (int i = 0; i < 4; ++i) {
        const float4 w = v[q][i];
        ss += w.x * w.x + w.y * w.y + w.z * w.z + w.w * w.w;
        uint2 pk; pk.x = cvt_pk_bf16(w.x, w.y); pk.y = cvt_pk_bf16(w.z, w.w);
        *(uint2*)(dst[q] + (i * 64 + lane) * 4) = pk;
        if (r0 + q < NTOK) {
          unsigned w8 = 0;
          w8 = __builtin_amdgcn_cvt_pk_fp8_f32(w.x, w.y, w8, false); w8 = __builtin_amdgcn_cvt_pk_fp8_f32(w.z, w.w, w8, true);
          *(unsigned*)(p->xb8 + (long)(r0 + q) * DM + (i * 64 + lane) * 4) = w8;
        }
      }
#pragma unroll
      for (int o = 32; o >= 1; o >>= 1) ss += shx(ss, o, lane);
      if (lane == 0) *sq[q] = ss;
    }
  }
  for (int i = blockIdx.x * 512 + tid; i < NTOK; i += gridDim.x * 512) p->ssq_x[NTOK + i] = 0.f;
}

struct G1Phase {
  PP p; int c, l, wr, wc, fr, fq; int dry;
  static constexpr int nM = CT / 256, nN = C_MRG / 256, NT1 = nM * nN;
  __device__ __forceinline__ void locate(int u, const bf16_t*& A, const bf16_t*& Bt, const float*& ssq, bf16_t*& out, int& ldo) const {
    const int i = blockIdx.x + u * gridDim.x;
    if (i < NT1) {
      int pm, pn; tile_remap(i, nM, nN, pm, pn);
      pn = nN - 1 - pn;
      A = p->xb + ((long)c * CT + pm * 256) * DM; Bt = p->WinT + ((long)l * INW + pn * 256) * DM;
      ssq = p->ssq_x + (long)l * NTOK + c * CT + pm * 256; out = p->proj + (long)pm * 256 * INW + pn * 256; ldo = INW;
    } else {
      const int j = i - NT1, ll = j >> 4, pm = (j & 15) >> 2, pn = j & 3;
      A = p->memb + (long)pm * 256 * DM; Bt = p->WmkvT + ((long)ll * DM + pn * 256) * DM;
      ssq = p->ssq_mem + pm * 256; out = p->mkv + ((long)ll * 1024 + pm * 256) * DM + pn * 256; ldo = DM;
    }
  }
  __device__ __forceinline__ GUnit unit(int u) const {
    const bf16_t *A, *Bt; const float* ssq; bf16_t* out; int ldo;
    locate(u, A, Bt, ssq, out, ldo);
    return GUnit{A, Bt};
  }
  float ssqp[2][4];
  __device__ __forceinline__ void preload(int u) {
    const bf16_t *A, *Bt; const float* ssq; bf16_t* out; int ldo;
    locate(u, A, Bt, ssq, out, ldo);
    const int t_ = otid(), w_ = t_ >> 6, l_ = t_ & 63, wr = w_ >> 2, fr = l_ & 15;
#pragma unroll
    for (int ai = 0; ai < 2; ++ai)
#pragma unroll
      for (int m = 0; m < 4; ++m) ssqp[ai][m] = ssq[ai * 128 + wr * 64 + m * 16 + fr];
  }
  __device__ __forceinline__ void epilogue(int u, f32x4 (&acc)[2][2][4][2]) const {
    const bf16_t *A, *Bt; const float* ssq; bf16_t* out; int ldo;
    locate(u, A, Bt, ssq, out, ldo);
    const int tcol = (int)((out - p->proj) % INW);
    const bool gate_tile = (ldo == INW) && tcol >= C_MRG;
    char* grow = (char*)(out - tcol);
    const int gcol0 = 2 * C_MRG + (tcol - C_MRG);
    const int t_ = otid(), w_ = t_ >> 6, l_ = t_ & 63, wr = w_ >> 2, wc = w_ & 3, fr = l_ & 15, fq = l_ >> 4;
#pragma unroll
    for (int ai = 0; ai < 2; ++ai)
#pragma unroll
      for (int m = 0; m < 4; ++m) {
        const int r = ai * 128 + wr * 64 + m * 16 + fr;
        const float rs = rsqrtf(ssqp[ai][m] * (1.0f / DM) + EPS);
        const unsigned ob = (unsigned)r * (unsigned)ldo + wc * 32 + fq * 8;
#pragma unroll
        for (int bj = 0; bj < 2; ++bj) {
          uint4 pk; uint2 gq;
#pragma unroll
          for (int n = 0; n < 2; ++n) {
            f32x4 v = acc[ai][bj][m][n];
            v[0] *= rs; v[1] *= rs; v[2] *= rs; v[3] *= rs;
            if (gate_tile) {
              const unsigned q0 = (unsigned)fminf(sigmoidf_(v[0]) * 256.f, 255.f), q1 = (unsigned)fminf(sigmoidf_(v[1]) * 256.f, 255.f);
              const unsigned q2 = (unsigned)fminf(sigmoidf_(v[2]) * 256.f, 255.f), q3 = (unsigned)fminf(sigmoidf_(v[3]) * 256.f, 255.f);
              const unsigned w = q0 | (q1 << 8) | (q2 << 16) | (q3 << 24);
              if (n == 0) gq.x = w; else gq.y = w;
            } else {
              if (n == 0) { pk.x = cvt_pk_bf16(v[0], v[1]); pk.y = cvt_pk_bf16(v[2], v[3]); }
              else { pk.z = cvt_pk_bf16(v[0], v[1]); pk.w = cvt_pk_bf16(v[2], v[3]); }
            }
          }
          if (!dry) {
            if (gate_tile) *(uint2*)(grow + ((unsigned)r * (unsigned)(INW * 2) + (unsigned)(gcol0 + bj * 128 + wc * 32 + fq * 8))) = gq;
            else *(uint4*)(out + (ob + bj * 128)) = pk;
          }
        }
      }
  }
};
struct G1bPhase {
  PP p; int c, l, wr, wc, fr, fq;
  __device__ __forceinline__ void tile(int u, int& pm, int& pn) const { tile_remap(blockIdx.x + u * gridDim.x, CT / 256, 16, pm, pn); }
  __device__ __forceinline__ GUnit unit(int u) const {
    int pm, pn; tile(u, pm, pn);
    return GUnit{(const bf16_t*)(p->xb8 + ((long)c * CT + pm * 256) * DM), (const bf16_t*)(p->Wg8 + ((long)l * 4096 + pn * 256) * DM)};
  }
  __device__ __forceinline__ void preload(int) const {}
  __device__ __forceinline__ void epilogue(int u, f32x4 (&acc)[2][2][4][2]) const {
    int pm, pn; tile(u, pm, pn);
    const float* ssq = p->ssq_x + (long)l * NTOK + c * CT + pm * 256;
    char* grow = (char*)(p->proj + (long)pm * 256 * INW) + 2 * C_MRG + pn * 256;
    const int t_ = otid(), w_ = t_ >> 6, l_ = t_ & 63, wr = w_ >> 2, wc = w_ & 3, fr = l_ & 15, fq = l_ >> 4;
    float k256 = 256.f, k255 = 255.f; asm volatile("" : "+v"(k256), "+v"(k255));
#pragma unroll
    for (int ai = 0; ai < 2; ++ai)
#pragma unroll
      for (int m = 0; m < 4; ++m) {
        const unsigned r = ai * 128 + wr * 64 + m * 16 + fr;
        const float rs = rsqrtf(ssq[r] * (1.0f / DM) + EPS) * (1.0f / 32.0f);
#pragma unroll
        for (int bj = 0; bj < 2; ++bj) {
          uint2 gq;
#pragma unroll
          for (int n = 0; n < 2; ++n) {
            const f32x4 v = acc[ai][bj][m][n];
            const unsigned q0 = (unsigned)fminf(sigmoidf_(v[0] * rs) * k256, k255), q1 = (unsigned)fminf(sigmoidf_(v[1] * rs) * k256, k255);
            const unsigned q2 = (unsigned)fminf(sigmoidf_(v[2] * rs) * k256, k255), q3 = (unsigned)fminf(sigmoidf_(v[3] * rs) * k256, k255);
            const unsigned w = q0 | (q1 << 8) | (q2 << 16) | (q3 << 24);
            if (n == 0) gq.x = w; else gq.y = w;
          }
          *(uint2*)(grow + (r * (unsigned)(INW * 2) + (unsigned)(bj * 128 + wc * 32 + fq * 8))) = gq;
        }
      }
  }
};
__device__ void phase_g1(PP p, int c, int l, int dry) {
  {
    const int tid = otid(), wid = tid >> 6, lane = tid & 63;
    G1bPhase pb;
    pb.p = p; pb.c = c; pb.l = l; pb.wr = wid >> 2; pb.wc = wid & 3; pb.fr = lane & 15; pb.fq = lane >> 4;
    const int nub = ((CT / 256) * 16 - (int)blockIdx.x + (int)gridDim.x - 1) / (int)gridDim.x;
    gemm_stream<4, true>(pb, nub, DM / 2, DM / 2, DM / 2);
  }
  const int tid = otid(), wid = tid >> 6, lane = tid & 63;
  G1Phase ph;
  ph.dry = dry; ph.p = p; ph.c = c; ph.l = l; ph.wr = wid >> 2; ph.wc = wid & 3; ph.fr = lane & 15; ph.fq = lane >> 4;
  const int ntiles = G1Phase::NT1 + ((c == 0 && l == 0) ? 32 : 0);
  const int nu = (ntiles - (int)blockIdx.x + (int)gridDim.x - 1) / (int)gridDim.x;
  gemm_stream<4, false>(ph, nu, DM, DM, DM);
}

struct G2Phase {
  PP p; int l, wr, wc, fr, fq;
  f32x4 mix[2][2][2][2];
  uint2 gpre[2][2][2];
  __device__ __forceinline__ void preload(int u) {
    const int i = blockIdx.x + (u >> 2) * gridDim.x, n4 = u & 3, pm = i >> 2, pn = i & 3;
    const char* gu = (const char*)(p->proj + (long)pm * 128 * INW) + 2 * C_MRG + n4 * DM + pn * 256;
    int fr = this->fr; asm volatile("" : "+v"(fr));
#pragma unroll
    for (int ai = 0; ai < 2; ++ai)
#pragma unroll
      for (int m = 0; m < 2; ++m) {
        const unsigned ob = (unsigned)(ai * 64 + wr * 32 + m * 16 + fr) * (unsigned)(INW * 2) + wc * 32 + fq * 8;
#pragma unroll
        for (int bj = 0; bj < 2; ++bj) gpre[ai][bj][m] = *(const uint2*)(gu + (ob + bj * 128));
      }
  }
  __device__ __forceinline__ GUnit unit(int u) const {
    const int i = blockIdx.x + (u >> 2) * gridDim.x, n4 = u & 3, pm = i >> 2, pn = i & 3;
    const int bcol = (n4 == 0) ? C_AQ : (n4 == 1) ? C_BQ : (n4 == 2) ? C_CG : C_MQ;
    return GUnit{p->proj + (long)pm * 128 * INW + bcol, p->WbrT + ((long)(l * 4 + n4) * DM + pn * 256) * 512};
  }
  __device__ __forceinline__ void epilogue(int u, f32x4 (&acc)[2][2][2][2]) {
    const int i = blockIdx.x + (u >> 2) * gridDim.x, n4 = u & 3, pm = i >> 2, pn = i & 3;
    bf16_t* prow = p->proj + (long)pm * 128 * INW;
    int fr = this->fr; asm volatile("" : "+v"(fr));
#pragma unroll
    for (int ai = 0; ai < 2; ++ai)
#pragma unroll
      for (int m = 0; m < 2; ++m)
#pragma unroll
        for (int bj = 0; bj < 2; ++bj) {
          const uint2 gv = gpre[ai][bj][m];
#pragma unroll
          for (int n = 0; n < 2; ++n) {
            const unsigned gw = n ? gv.y : gv.x;
            f32x4 v = acc[ai][bj][m][n];
            f32x4 mv = (n4 == 0) ? f32x4{0.f, 0.f, 0.f, 0.f} : mix[ai][bj][m][n];
            mv[0] += ((float)(gw & 255u) + 0.5f) * (1.0f / 256.0f) * v[0];
            mv[1] += ((float)((gw >> 8) & 255u) + 0.5f) * (1.0f / 256.0f) * v[1];
            mv[2] += ((float)((gw >> 16) & 255u) + 0.5f) * (1.0f / 256.0f) * v[2];
            mv[3] += ((float)(gw >> 24) + 0.5f) * (1.0f / 256.0f) * v[3];
            mix[ai][bj][m][n] = mv;
          }
        }
    if (n4 == 3) {
#pragma unroll
      for (int ai = 0; ai < 2; ++ai)
#pragma unroll
        for (int m = 0; m < 2; ++m) {
          const int r = ai * 64 + wr * 32 + m * 16 + fr;
          bf16_t* o = prow + (long)r * INW + C_MIX + pn * 256 + wc * 32 + fq * 8;
#pragma unroll
          for (int bj = 0; bj < 2; ++bj) {
            const f32x4 v0 = mix[ai][bj][m][0], v1 = mix[ai][bj][m][1];
            uint4 pk; pk.x = cvt_pk_bf16(v0[0], v0[1]); pk.y = cvt_pk_bf16(v0[2], v0[3]); pk.z = cvt_pk_bf16(v1[0], v1[1]); pk.w = cvt_pk_bf16(v1[2], v1[3]);
            *(uint4*)(o + bj * 128) = pk;
          }
        }
    }
  }
};
__device__ void phase_g2(PP p, int c, int l) {
  const int tid = otid(), wid = tid >> 6, lane = tid & 63;
  G2Phase ph;
  ph.p = p; ph.l = l; ph.wr = wid >> 2; ph.wc = wid & 3; ph.fr = lane & 15; ph.fq = lane >> 4;
#pragma unroll
  for (int a = 0; a < 2; ++a)
#pragma unroll
    for (int b = 0; b < 2; ++b)
#pragma unroll
      for (int m = 0; m < 2; ++m)
#pragma unroll
        for (int n = 0; n < 2; ++n) ph.mix[a][b][m][n] = f32x4{0.f, 0.f, 0.f, 0.f};
  constexpr int NT = (CT / 128) * 4;
  const int ntl = (NT - (int)blockIdx.x + (int)gridDim.x - 1) / (int)gridDim.x;
  gemm_stream<2, false>(ph, ntl * 4, INW, 512, 512);
}

struct G3Phase {
  PP p; int c, l, wr, wc, fr, fq;
  __device__ __forceinline__ GUnit unit(int u) const {
    const int i = blockIdx.x + u * gridDim.x, pm = i >> 2, pn = i & 3;
    return GUnit{p->proj + (long)pm * 256 * INW + C_MIX, p->WoutT + ((long)l * DM + pn * 256) * DM};
  }
  __device__ __forceinline__ void preload(int) const {}
  __device__ __forceinline__ void epilogue(int u, f32x4 (&acc)[2][2][4][2]) const {
    const int i = blockIdx.x + u * gridDim.x, pm = i >> 2, pn = i & 3;
    const long ubase = ((long)c * CT + pm * 256) * DM + pn * 256;
    const float* xu = ((l == 0) ? p->x : p->out) + ubase;
    float* ou = p->out + ubase;
    bf16_t* xbu = p->xb + ubase;
    unsigned char* x8u = p->xb8 + ubase;
    float* squ = p->ssq_x + NTOK + (long)c * CT + pm * 256;
    int fr = this->fr; asm volatile("" : "+v"(fr));
#pragma unroll
    for (int ai = 0; ai < 2; ++ai)
#pragma unroll
      for (int m = 0; m < 4; ++m) {
        const unsigned rl = ai * 128 + wr * 64 + m * 16 + fr;
        const unsigned ob = rl * DM + wc * 32 + fq * 8;
        float ss = 0.f;
#pragma unroll
        for (int bj = 0; bj < 2; ++bj) {
          uint4 pk; uint2 q8;
#pragma unroll
          for (int n = 0; n < 2; ++n) {
            const unsigned off = ob + bj * 128 + n * 4;
            float4 xo = *(const float4*)(xu + off);
            f32x4 v = acc[ai][bj][m][n];
            float4 xn; xn.x = xo.x + v[0]; xn.y = xo.y + v[1]; xn.z = xo.z + v[2]; xn.w = xo.w + v[3];
            *(float4*)(ou + off) = xn;
            if (l == 0) {
              if (n == 0) { pk.x = cvt_pk_bf16(xn.x, xn.y); pk.y = cvt_pk_bf16(xn.z, xn.w); }
              else { pk.z = cvt_pk_bf16(xn.x, xn.y); pk.w = cvt_pk_bf16(xn.z, xn.w); }
              ss += xn.x * xn.x + xn.y * xn.y + xn.z * xn.z + xn.w * xn.w;
              unsigned w8 = 0;
              w8 = __builtin_amdgcn_cvt_pk_fp8_f32(xn.x, xn.y, w8, false); w8 = __builtin_amdgcn_cvt_pk_fp8_f32(xn.z, xn.w, w8, true);
              if (n == 0) q8.x = w8; else q8.y = w8;
            }
          }
          if (l == 0) {
            *(uint4*)(xbu + (ob + bj * 128)) = pk;
            *(uint2*)(x8u + (ob + bj * 128)) = q8;
          }
        }
        if (l == 0) {
          { const int ln_ = fq * 16 + fr; ss += shx(ss, 16, ln_); ss += shx(ss, 32, ln_); }
          if (fq == 0) atomicAdd(squ + rl, ss);
        }
      }
  }
};
__device__ void phase_g3(PP p, int c, int l) {
  const int tid = otid(), wid = tid >> 6, lane = tid & 63;
  G3Phase ph{p, c, l, wid >> 2, wid & 3, lane & 15, lane >> 4};
  constexpr int NT = (CT / 256) * 4;
  const int nu = (NT - (int)blockIdx.x + (int)gridDim.x - 1) / (int)gridDim.x;
  gemm_stream<4, false>(ph, nu, INW, DM, DM);
}

template <int D, int MODE>
__device__ void attn_item(PP p, int c, int l, int bb, int qb0, int h0) {
  constexpr int NSUB = (MODE == 0) ? 4 : (MODE == 2) ? 2 : 1;
  constexpr int KP = D + 8, VP = 264, NKS = D / 32, NDS = D / 16;
  constexpr int TPR = D / 8, RPP = 512 / TPR, NPK = 256 / RPP, NPV = NPK / 2;
  bf16_t* Ks = (bf16_t*)smem;
  bf16_t* Vt = (bf16_t*)(smem + 256 * KP * 2);
  int* flags = (int*)(smem + 256 * KP * 2 + D * VP * 2);
  const int tid = otid(), wid = tid >> 6, lane = tid & 63, fr = lane & 15, fq = lane >> 4;
  const float sc = LOG2E * (D == 64 ? 0.125f : 0.08838834764831845f);
  const bf16_t *Kbase, *Vbase; int ldk; const float* kg = nullptr;
  if (MODE == 0) { Kbase = p->proj + (long)bb * SEQ * INW + C_AK + (h0 >> 2) * 64; Vbase = p->proj + (long)bb * SEQ * INW + C_AV + (h0 >> 2) * 64; ldk = INW; kg = p->swa_k_gain + l * 64; }
  else if (MODE == 1) { Kbase = p->proj + (long)bb * SEQ * INW + C_BK + h0 * 64; Vbase = p->proj + (long)bb * SEQ * INW + C_BV + h0 * 64; ldk = INW; }
  else { const int gb = c * CB + bb; Kbase = p->mkv + ((long)l * 1024 + gb * 256) * DM + h0 * 128; Vbase = Kbase + 512; ldk = DM; kg = p->mem_k_gain + l * 128; }

#pragma unroll 1
  for (int sub = 0; sub < NSUB; ++sub) {
  const int h = h0 + ((MODE == 0) ? sub : 0), qb = qb0 + ((MODE == 2) ? sub : 0);
  const int qcol = (MODE == 0 ? C_AQ : MODE == 1 ? C_BQ : C_MQ) + h * D;
  const int gcol = (MODE == 0 ? C_AG : MODE == 1 ? C_BG : C_MG) + h * D;
  const long rowQ = (long)bb * SEQ + qb * 128 + wid * 16 + fr;
  bf16_t* qptr = p->proj + rowQ * INW + qcol;
  const int qi = wid * 16 + fr;

  int krow0, nk;
  if (MODE == 2) { krow0 = 0; nk = 256; } else if (qb > 0) { krow0 = qb * 128 - 128; nk = 256; } else { krow0 = 0; nk = 128; }
  const int cc = tid % TPR, trow = tid / TPR;
  uint4 kreg[NPK], vreg[NPV][2];
  bool first = true;
#define ATTN_ISSUE_LOADS_() do { \
    _Pragma("unroll") for (int ps = 0; ps < NPK; ++ps) \
      if (ps * RPP < nk) kreg[ps] = *(const uint4*)(Kbase + (long)(krow0 + ps * RPP + trow) * ldk + cc * 8); \
    _Pragma("unroll") for (int ps = 0; ps < NPV; ++ps) \
      if (ps * 2 * RPP < nk) { \
        const bf16_t* vs = Vbase + (long)(krow0 + ps * 2 * RPP + 2 * trow) * ldk + cc * 8; \
        vreg[ps][0] = *(const uint4*)vs; vreg[ps][1] = *(const uint4*)(vs + ldk); \
      } } while (0)
  if (sub == 0) ATTN_ISSUE_LOADS_();
  uint2 gvp[NDS];
  {
    const bf16_t* gp0 = p->proj + rowQ * INW + gcol + 4 * fq;
#pragma unroll
    for (int d = 0; d < NDS; ++d) gvp[d] = *(const uint2*)(gp0 + d * 16);
  }
  bf16x8 qf[NKS];
  {
    float qv[NKS][8]; float ss = 0.f;
#pragma unroll
    for (int ks = 0; ks < NKS; ++ks) {
      uint4 u = *(const uint4*)(qptr + ks * 32 + fq * 8);
      qv[ks][0] = bflo(u.x); qv[ks][1] = bfhi(u.x); qv[ks][2] = bflo(u.y); qv[ks][3] = bfhi(u.y);
      qv[ks][4] = bflo(u.z); qv[ks][5] = bfhi(u.z); qv[ks][6] = bflo(u.w); qv[ks][7] = bfhi(u.w);
#pragma unroll
      for (int i = 0; i < 8; ++i) ss += qv[ks][i] * qv[ks][i];
    }
    float rs = sc;
    const float* qg = (MODE == 0) ? (p->swa_q_gain + l * 64) : (p->mem_q_gain + l * 128);
    if (MODE != 1) {
      ss += shx(ss, 16, lane); ss += shx(ss, 32, lane);
      rs = rsqrtf(ss * (1.0f / D) + EPS) * sc;
    }
#pragma unroll
    for (int ks = 0; ks < NKS; ++ks) {
      float g[8];
#pragma unroll
      for (int i = 0; i < 8; ++i) g[i] = (MODE != 1) ? qg[ks * 32 + fq * 8 + i] * rs : rs;
      union { unsigned u[4]; bf16x8 v; } cv;
#pragma unroll
      for (int i = 0; i < 4; ++i) cv.u[i] = cvt_pk_bf16(qv[ks][2 * i] * g[2 * i], qv[ks][2 * i + 1] * g[2 * i + 1]);
      qf[ks] = cv.v;
    }
  }

  bf16x8 uop[2];
  if (MODE == 1) {
    int onev = 0x3F80; asm volatile("" : "+v"(onev));
#pragma unroll
    for (int ss_ = 0; ss_ < 2; ++ss_) {
      const int srow = ss_ * 16 + fr;
#pragma unroll
      for (int i = 0; i < 8; ++i) {
        const int j = (i < 4) ? (4 * fq + i) : (16 + 4 * fq + (i - 4));
        uop[ss_][i] = (j >= srow) ? (short)onev : (short)0;
      }
    }
  }

  f32x4 o[NDS];
#pragma unroll
  for (int d = 0; d < NDS; ++d) o[d] = f32x4{0.f, 0.f, 0.f, 0.f};
  float m_run = -1e30f, lsum = 0.f, R = 0.f;
  if (MODE == 0) m_run = p->swa_sinks[l * 8 + h] * LOG2E;

  bool wdone = false;
#pragma unroll 1
  for (;;) {
    if (sub == 0) {
    __syncthreads();
    {
      if (!first) ATTN_ISSUE_LOADS_();
      first = false;
#pragma unroll
      for (int ps = 0; ps < NPK; ++ps)
        if (ps * RPP < nk) {
          uint4 u = kreg[ps];
          if (MODE != 1) {
            float f[8] = {bflo(u.x), bfhi(u.x), bflo(u.y), bfhi(u.y), bflo(u.z), bfhi(u.z), bflo(u.w), bfhi(u.w)};
            float ss = 0.f;
#pragma unroll
            for (int i = 0; i < 8; ++i) ss += f[i] * f[i];
#pragma unroll
            for (int off = 1; off < TPR; off <<= 1) ss += shx(ss, off, lane);
            const float rs = rsqrtf(ss * (1.0f / D) + EPS);
#pragma unroll
            for (int i = 0; i < 8; ++i) f[i] *= rs * kg[cc * 8 + i];
            u.x = cvt_pk_bf16(f[0], f[1]); u.y = cvt_pk_bf16(f[2], f[3]); u.z = cvt_pk_bf16(f[4], f[5]); u.w = cvt_pk_bf16(f[6], f[7]);
          }
          *(uint4*)(Ks + (ps * RPP + trow) * KP + cc * 8) = u;
        }
#pragma unroll
      for (int ps = 0; ps < NPV; ++ps)
        if (ps * 2 * RPP < nk) {
          const int r = ps * 2 * RPP + 2 * trow;
          unsigned* vd = (unsigned*)(Vt + (cc * 8) * VP + (r ^ ((cc & 7) << 3)));
          const uint4 a = vreg[ps][0], b = vreg[ps][1];
          vd[0 * (VP / 2)] = (a.x & 0xffffu) | (b.x << 16); vd[1 * (VP / 2)] = (a.x >> 16) | (b.x & 0xffff0000u);
          vd[2 * (VP / 2)] = (a.y & 0xffffu) | (b.y << 16); vd[3 * (VP / 2)] = (a.y >> 16) | (b.y & 0xffff0000u);
          vd[4 * (VP / 2)] = (a.z & 0xffffu) | (b.z << 16); vd[5 * (VP / 2)] = (a.z >> 16) | (b.z & 0xffff0000u);
          vd[6 * (VP / 2)] = (a.w & 0xffffu) | (b.w << 16); vd[7 * (VP / 2)] = (a.w >> 16) | (b.w & 0xffff0000u);
        }
    }
    __syncthreads();
    }

    const int relbase = krow0 - qb * 128;
#pragma unroll 1
    for (int g = (nk >> 5) - 1; g >= 0; --g) {
      const int r0 = relbase + g * 32;
      bool masked = false;
      if (MODE == 1) {
        if (wdone) continue;
        if (r0 >= wid * 16 + 15) continue;
        masked = (r0 + 31 >= wid * 16);
      }
      if (MODE == 0) {
        if (r0 > wid * 16 + 15 || r0 + 31 <= wid * 16 - 128) continue;
      }
      f32x4 s[2];
      __builtin_amdgcn_s_setprio(1);
#pragma unroll
      for (int sub = 0; sub < 2; ++sub) {
        s[sub] = f32x4{0.f, 0.f, 0.f, 0.f};
#pragma unroll
        for (int ks = 0; ks < NKS; ++ks) {
          bf16x8 a = *(const bf16x8*)(Ks + (g * 32 + sub * 16 + fr) * KP + ks * 32 + fq * 8);
          s[sub] = __builtin_amdgcn_mfma_f32_16x16x32_bf16(a, qf[ks], s[sub], 0, 0, 0);
        }
      }
      __builtin_amdgcn_s_setprio(0);
      float w[8];
      if (MODE == 1) {
        float Lv[8], tot = 0.f; bool vld[8];
#pragma unroll
        for (int i = 0; i < 8; ++i) {
          const int rel = r0 + (i >> 2) * 16 + fq * 4 + (i & 3);
          vld[i] = !masked || (rel < qi);
          const float z2 = s[i >> 2][i & 3];
          const float lv = -(fmaxf(z2, 0.f) + flog2(1.0f + fexp2(-fabsf(z2))));
          Lv[i] = vld[i] ? lv : 0.f;
          tot += Lv[i];
        }
        tot += shx(tot, 16, lane); tot += shx(tot, 32, lane);
        union { unsigned u[4]; bf16x8 v; } hi, lo;
#pragma unroll
        for (int i = 0; i < 4; ++i) {
          const unsigned hp = cvt_pk_bf16(Lv[2 * i], Lv[2 * i + 1]);
          hi.u[i] = hp;
          lo.u[i] = cvt_pk_bf16(Lv[2 * i] - bflo(hp), Lv[2 * i + 1] - bfhi(hp));
        }
        f32x4 cs[2];
#pragma unroll
        for (int ss_ = 0; ss_ < 2; ++ss_) {
          cs[ss_] = f32x4{0.f, 0.f, 0.f, 0.f};
          cs[ss_] = __builtin_amdgcn_mfma_f32_16x16x32_bf16(uop[ss_], hi.v, cs[ss_], 0, 0, 0);
          cs[ss_] = __builtin_amdgcn_mfma_f32_16x16x32_bf16(uop[ss_], lo.v, cs[ss_], 0, 0, 0);
        }
#pragma unroll
        for (int i = 0; i < 8; ++i) {
          const float e = s[i >> 2][i & 3] + cs[i >> 2][i & 3] + R;
          w[i] = vld[i] ? fexp2(e) : 0.f;
        }
        R += tot;
        wdone = __all(R < -150.0f);
      } else {
        float gmax = -1e30f;
#pragma unroll
        for (int i = 0; i < 8; ++i) {
          bool v = true;
          if (MODE == 0) { const int rel = r0 + (i >> 2) * 16 + fq * 4 + (i & 3); v = (rel <= qi) && (rel > qi - 128); }
          w[i] = v ? s[i >> 2][i & 3] : -1e30f;
          gmax = fmaxf(gmax, w[i]);
        }
        gmax = fmaxf(gmax, shx(gmax, 16, lane)); gmax = fmaxf(gmax, shx(gmax, 32, lane));
        const float m_new = fmaxf(m_run, gmax);
        const float alpha = fexp2(m_run - m_new);
        float ps = 0.f;
#pragma unroll
        for (int i = 0; i < 8; ++i) { w[i] = fexp2(w[i] - m_new); ps += w[i]; }
        lsum = lsum * alpha + ps;
#pragma unroll
        for (int d = 0; d < NDS; ++d) { o[d][0] *= alpha; o[d][1] *= alpha; o[d][2] *= alpha; o[d][3] *= alpha; }
        m_run = m_new;
      }
      union { unsigned u[4]; bf16x8 v; } wb;
#pragma unroll
      for (int i = 0; i < 4; ++i) wb.u[i] = cvt_pk_bf16(w[2 * i], w[2 * i + 1]);
      __builtin_amdgcn_s_setprio(1);
#pragma unroll
      for (int d = 0; d < NDS; ++d) {
        const int sw = ((2 * d + (fr >> 3)) & 7) << 3;
        const bf16_t* vrow = Vt + (d * 16 + fr) * VP;
        union { uint2 h[2]; bf16x8 v; } a;
        a.h[0] = *(const uint2*)(vrow + ((g * 32 + 4 * fq) ^ sw)); a.h[1] = *(const uint2*)(vrow + ((g * 32 + 16 + 4 * fq) ^ sw));
        o[d] = __builtin_amdgcn_mfma_f32_16x16x32_bf16(a.v, wb.v, o[d], 0, 0, 0);
      }
      __builtin_amdgcn_s_setprio(0);
    }
    if (MODE != 1) break;
    __syncthreads();
    if (lane == 0) flags[wid] = wdone ? 1 : 0;
    __syncthreads();
    int all = 1;
#pragma unroll
    for (int i = 0; i < 8; ++i) all &= flags[i];
    if (all || krow0 == 0) break;
    krow0 -= 128; nk = 128;
  }

  float inv = 1.0f;
  if (MODE != 1) {
    lsum += shx(lsum, 16, lane); lsum += shx(lsum, 32, lane);
    if (MODE == 0) lsum += fexp2(p->swa_sinks[l * 8 + h] * LOG2E - m_run);
    inv = 1.0f / lsum;
  }
#pragma unroll
  for (int d = 0; d < NDS; ++d) {
    const uint2 gv = gvp[d];
    uint2 pk;
    pk.x = cvt_pk_bf16(o[d][0] * inv * siluf_(bflo(gv.x)), o[d][1] * inv * siluf_(bfhi(gv.x)));
    pk.y = cvt_pk_bf16(o[d][2] * inv * siluf_(bflo(gv.y)), o[d][3] * inv * siluf_(bfhi(gv.y)));
    *(uint2*)(qptr + d * 16 + 4 * fq) = pk;
  }
  }
}

#undef ATTN_ISSUE_LOADS_

template <int APPLY>
__device__ void lru_item(PP p, int l, int bb, int ck, int nb, unsigned epoch) {
  bf16_t* cxs = (bf16_t*)smem;
  bf16_t* xcs = (bf16_t*)(smem + 16896);
  bf16_t* wta = (bf16_t*)(smem + 35328);
  bf16_t* wtx = (bf16_t*)(smem + 44544);
  float* as_ = (float*)(smem + 53760);
  float* bs_ = (float*)(smem + 86528);
  float* segA = (float*)(smem + 119296);
  float* segH = (float*)(smem + 121344);
  float* cin = (float*)(smem + 123392);
  const int tid = otid(), wid = tid >> 6, lane = tid & 63, fr = lane & 15, fq = lane >> 4;
  float* partA = (float*)(smem + 125440);
  float* partH = (float*)(smem + 127488);
  const long row0 = (long)bb * SEQ + ck * 128;
  __syncthreads();
  bf16_t cgv[16];
  if (APPLY) {
    const int ch = tid & 63, seg = tid >> 6;
#pragma unroll
    for (int i = 0; i < 16; ++i) cgv[i] = p->proj[(row0 + seg * 16 + i) * INW + C_CG + nb * 64 + ch];
  }
  if (APPLY == 1) {
    const int ch = tid & 63, w = tid >> 6;
    const int lo = (ck * w) >> 3, hi = (ck * (w + 1)) >> 3;
    const float* pa = p->lruA + (long)(bb * 64) * 512 + nb * 64 + ch;
    const float* ph = p->lruH + (long)(bb * 64) * 512 + nb * 64 + ch;
    float av[8], hv[8];
#pragma unroll
    for (int i = 0; i < 8; ++i) { const bool ok = lo + i < hi; av[i] = ok ? pa[(lo + i) * 512] : 1.0f; hv[i] = ok ? ph[(lo + i) * 512] : 0.0f; }
    float Ap = 1.f, Hp = 0.f;
#pragma unroll
    for (int i = 0; i < 8; ++i) { Hp = av[i] * Hp + hv[i]; Ap *= av[i]; }
    partA[w * 64 + ch] = Ap; partH[w * 64 + ch] = Hp;
  }
  for (int s = tid; s < 131 * 8; s += 512) {
    const int r = s >> 3, cc = s & 7, t = ck * 128 + r - 3;
    uint4 u = make_uint4(0, 0, 0, 0);
    if (t >= 0) u = *(const uint4*)(p->proj + ((long)bb * SEQ + t) * INW + C_CX + nb * 64 + cc * 8);
    *(uint4*)(cxs + r * 64 + cc * 8) = u;
  }
  {
    const bf16_t* wsrc = p->lruWT + (long)((l * 8 + nb) * 2) * 4096;
    const int d = tid >> 3, c8 = (tid & 7) * 8;
    *(uint4*)(wta + d * 72 + c8) = *(const uint4*)(wsrc + d * 64 + c8);
    *(uint4*)(wtx + d * 72 + c8) = *(const uint4*)(wsrc + 4096 + d * 64 + c8);
  }
  __syncthreads();
  {
    const int ch = tid & 63, gch = nb * 64 + ch;
    const float* cw = p->conv_w + (long)l * 4 * 512 + gch;
    const float w0 = cw[0], w1 = cw[512], w2 = cw[1024], w3 = cw[1536], cb = p->conv_b[l * 512 + gch];
#pragma unroll
    for (int i = 0; i < 16; ++i) {
      const int tok = (tid >> 6) + 8 * i;
      const float v = cb + w0 * bf2f(cxs[(tok + 0) * 64 + ch]) + w1 * bf2f(cxs[(tok + 1) * 64 + ch]) +
                      w2 * bf2f(cxs[(tok + 2) * 64 + ch]) + w3 * bf2f(cxs[(tok + 3) * 64 + ch]);
      xcs[tok * 72 + ch] = f2bf(v);
    }
  }
  __syncthreads();
  {
    bf16x8 a[2];
#pragma unroll
    for (int ks = 0; ks < 2; ++ks) a[ks] = *(const bf16x8*)(xcs + (wid * 16 + fr) * 72 + ks * 32 + fq * 8);
#pragma unroll
    for (int nk = 0; nk < 4; ++nk) {
      f32x4 ra = f32x4{0.f, 0.f, 0.f, 0.f}, ia = f32x4{0.f, 0.f, 0.f, 0.f};
#pragma unroll
      for (int ks = 0; ks < 2; ++ks) {
        bf16x8 ba = *(const bf16x8*)(wta + (nk * 16 + fr) * 72 + ks * 32 + fq * 8);
        bf16x8 bx = *(const bf16x8*)(wtx + (nk * 16 + fr) * 72 + ks * 32 + fq * 8);
        ra = __builtin_amdgcn_mfma_f32_16x16x32_bf16(a[ks], ba, ra, 0, 0, 0);
        ia = __builtin_amdgcn_mfma_f32_16x16x32_bf16(a[ks], bx, ia, 0, 0, 0);
      }
      const int ch = nk * 16 + fr, gch = nb * 64 + ch;
      const float ba_ = p->lru_b_a[l * 512 + gch], bx_ = p->lru_b_x[l * 512 + gch];
      const float sp = log1pf(__expf(-p->lru_lambda[l * 512 + gch]));
      const float* cw = p->conv_w + (long)l * 4 * 512 + gch;
      const float w0 = cw[0], w1 = cw[512], w2 = cw[1024], w3 = cw[1536], cb = p->conv_b[l * 512 + gch];
#pragma unroll
      for (int reg = 0; reg < 4; ++reg) {
        const int tok = wid * 16 + 4 * fq + reg;
        const float r = sigmoidf_(ra[reg] + ba_), ig = sigmoidf_(ia[reg] + bx_);
        const float log_a = -8.0f * r * sp;
        const float av = __expf(log_a);
        const float mult = sqrtf(fmaxf(1.0f - __expf(2.0f * log_a), 0.f));
        const float xc = cb + w0 * bf2f(cxs[(tok + 0) * 64 + ch]) + w1 * bf2f(cxs[(tok + 1) * 64 + ch]) +
                         w2 * bf2f(cxs[(tok + 2) * 64 + ch]) + w3 * bf2f(cxs[(tok + 3) * 64 + ch]);
        as_[tok * 64 + ch] = av;
        bs_[tok * 64 + ch] = mult * ig * xc;
      }
    }
  }
  __syncthreads();
  {
    const int ch = tid & 63, seg = tid >> 6;
    float P = 1.f, hh = 0.f;
#pragma unroll
    for (int i = 0; i < 16; ++i) {
      const int idx = (seg * 16 + i) * 64 + ch;
      const float a = as_[idx], b = bs_[idx];
      hh = a * hh + b; P *= a;
      as_[idx] = P; bs_[idx] = hh;
    }
    segA[seg * 64 + ch] = P; segH[seg * 64 + ch] = hh;
  }
  __syncthreads();
  if (APPLY == 2) {
    unsigned long long* tg = p->lruT + ((long)(bb * 64) * 512 + nb * 64) * 2;
    if (tid < 64) {
      const int ch = tid;
      float hl = 0.f, At = 1.f;
#pragma unroll
      for (int sg = 0; sg < 8; ++sg) { const float a = segA[sg * 64 + ch]; hl = a * hl + segH[sg * 64 + ch]; At *= a; }
      unsigned long long* dst = tg + ((long)ck * 512 + ch) * 2;
      __hip_atomic_store(dst, ((unsigned long long)epoch << 32) | __float_as_uint(At), __ATOMIC_RELAXED, __HIP_MEMORY_SCOPE_AGENT);
      __hip_atomic_store(dst + 1, ((unsigned long long)epoch << 32) | __float_as_uint(hl), __ATOMIC_RELAXED, __HIP_MEMORY_SCOPE_AGENT);
    }
    {
      const int ch = tid & 63, w = tid >> 6;
      const int lo = (ck * w) >> 3, hi = (ck * (w + 1)) >> 3;
      unsigned long long wa[8], wh[8];
      unsigned spins = 0;
      for (;;) {
        bool ok = true;
#pragma unroll
        for (int i = 0; i < 8; ++i) {
          if (lo + i < hi) {
            const unsigned long long* src = tg + ((long)(lo + i) * 512 + ch) * 2;
            wa[i] = __hip_atomic_load(src, __ATOMIC_RELAXED, __HIP_MEMORY_SCOPE_AGENT);
            wh[i] = __hip_atomic_load(src + 1, __ATOMIC_RELAXED, __HIP_MEMORY_SCOPE_AGENT);
            ok = ok && ((unsigned)(wa[i] >> 32) == epoch) && ((unsigned)(wh[i] >> 32) == epoch);
          }
        }
        if (ok || ++spins > (1u << 20)) break;
        __builtin_amdgcn_s_sleep(2);
      }
      float Ap = 1.f, Hp = 0.f;
#pragma unroll
      for (int i = 0; i < 8; ++i)
        if (lo + i < hi) { const float a = __uint_as_float((unsigned)wa[i]), hvv = __uint_as_float((unsigned)wh[i]); Hp = a * Hp + hvv; Ap *= a; }
      partA[w * 64 + ch] = Ap; partH[w * 64 + ch] = Hp;
    }
    __syncthreads();
  }
  if (tid < 64) {
    const int ch = tid;
    float carry = 0.f;
    if (APPLY) {
#pragma unroll
      for (int w = 0; w < 8; ++w) carry = partA[w * 64 + ch] * carry + partH[w * 64 + ch];
    }
    float At = 1.f;
#pragma unroll
    for (int sg = 0; sg < 8; ++sg) {
      cin[sg * 64 + ch] = carry;
      const float a = segA[sg * 64 + ch];
      carry = a * carry + segH[sg * 64 + ch]; At *= a;
    }
    if (!APPLY) {
      p->lruA[(long)(bb * 64 + ck) * 512 + nb * 64 + ch] = At;
      p->lruH[(long)(bb * 64 + ck) * 512 + nb * 64 + ch] = carry;
    }
  }
  if (APPLY) {
    __syncthreads();
    const int ch = tid & 63, seg = tid >> 6;
    const float c0 = cin[seg * 64 + ch];
#pragma unroll
    for (int i = 0; i < 16; ++i) {
      const int tok = seg * 16 + i, idx = tok * 64 + ch;
      const float hv = bs_[idx] + as_[idx] * c0;
      bf16_t* gp = p->proj + (row0 + tok) * INW + C_CG + nb * 64 + ch;
      *gp = f2bf(hv * siluf_(bf2f(cgv[i])));
    }
  }
}

__device__ void phase_mix(PP p, int c, int l) {
  constexpr int N_SWA = CB * 64 * 2, N_MEM = CB * 32 * 4, N_SB = CB * 64 * 8, N_LRU = CB * 64 * 8;
  const unsigned epoch = (unsigned)(c * 2 + l) + 1u;
  for (int i = blockIdx.x; i < N_SWA + N_MEM + N_SB + N_LRU; i += gridDim.x) {
    if (i < N_SWA) { const int kvh = i & 1, qb = (i >> 1) & 63, bb = i >> 7; attn_item<64, 0>(p, c, l, bb, qb, kvh * 4); }
    else if (i < N_SWA + N_MEM) { const int j = i - N_SWA, h = j & 3, qg = (j >> 2) & 31, bb = j >> 7; attn_item<128, 2>(p, c, l, bb, qg * 2, h); }
    else if (i < N_SWA + N_MEM + N_SB) { const int j = i - N_SWA - N_MEM, h = j & 7, qb = (j >> 3) & 63, bb = j >> 9; attn_item<64, 1>(p, c, l, bb, qb, h); }
    else { const int j = i - N_SWA - N_MEM - N_SB, nb = j & 7, ck = (j >> 3) & 63, bb = j >> 9; lru_item<2>(p, l, bb, ck, nb, epoch); }
  }
}

#define XB_TMO      128
#define XB_XCNT(j)  (256  + 64 * (j))
#define XB_XSUB(j)  (1280 + 64 * (j))
#define XB_XGEN(j)  (2304 + 64 * (j))
#define XB_TOP      3328
#define XB_TOPGEN   3392
#define XCD_BAR_WORDS 3456
#define XB_SPIN_CAP (1u << 18)
#define LAS __attribute__((address_space(3)))

__device__ __forceinline__ unsigned xb_ld(unsigned* p)              { return __hip_atomic_load(p, __ATOMIC_RELAXED, __HIP_MEMORY_SCOPE_AGENT); }
__device__ __forceinline__ unsigned xb_add(unsigned* p, unsigned v) { return __hip_atomic_fetch_add(p, v, __ATOMIC_RELAXED, __HIP_MEMORY_SCOPE_AGENT); }
__device__ __forceinline__ unsigned xb_xcc_id() { return (unsigned)__builtin_amdgcn_s_getreg((3 << 11) | 20) & 0xFu; }
#define XB_SPIN(cond, bar) do { unsigned _sp = 0; while (cond) { __builtin_amdgcn_s_sleep(1); \
    if ((++_sp & 255u) == 0u) { if (xb_ld(&(bar)[XB_TMO])) break; if (_sp > XB_SPIN_CAP) { atomicAdd(&(bar)[XB_TMO], 1u); break; } } } } while (0)

struct XcdBarrier {
    unsigned* bar; unsigned x;
    volatile LAS unsigned* st;
};

__device__ __forceinline__ XcdBarrier xcd_barrier_post(unsigned* bar, volatile LAS unsigned* st) {
    XcdBarrier b; b.bar = bar; b.x = xb_xcc_id(); b.st = st;
    if (otid() == 0) (void)xb_add(&bar[XB_XCNT(b.x)], 1u);
    return b;
}
__device__ __forceinline__ void xcd_barrier_complete(unsigned* bar, unsigned x, unsigned& nloc, unsigned& nx) {
    const unsigned G = gridDim.x * gridDim.y * gridDim.z;
    unsigned sum, cnt, mine, sp = 0u;
    for (;;) {
        sum = 0u; cnt = 0u; mine = 0u;
#pragma unroll
        for (unsigned j = 0; j < 16; ++j) { const unsigned c = xb_ld(&bar[XB_XCNT(j)]); sum += c; cnt += (c > 0u) ? 1u : 0u; mine = (j == x) ? c : mine; }
        if (sum == G) break;
        __builtin_amdgcn_s_sleep(1);
        if ((++sp & 255u) == 0u) { if (xb_ld(&bar[XB_TMO])) break; if (sp > XB_SPIN_CAP) { atomicAdd(&bar[XB_TMO], 1u); break; } }
    }
    nloc = mine > 0u ? mine : 1u; nx = cnt > 0u ? cnt : 1u;
}

__device__ __forceinline__ void xcd_barrier(const XcdBarrier& b) {
    asm volatile("s_waitcnt vmcnt(0)" ::: "memory");
    __syncthreads();
    if (otid() == 0) {
        unsigned* bar = b.bar;
        __builtin_amdgcn_s_waitcnt(0);
        unsigned nloc = b.st[0], nx = b.st[1];
        if (nloc == 0u) { xcd_barrier_complete(bar, b.x, nloc, nx); b.st[0] = nloc; b.st[1] = nx; }
        const unsigned old = xb_add(&bar[XB_XSUB(b.x)], 1u);
        const unsigned gen = old / nloc;
        if (old + 1u == (gen + 1u) * nloc) {
            __builtin_amdgcn_fence(__ATOMIC_RELEASE, "agent");
            asm volatile("s_waitcnt vmcnt(0)" ::: "memory");
            const unsigned og = xb_add(&bar[XB_TOP], 1u);
            const unsigned tg = og / nx;
            if (og + 1u == (tg + 1u) * nx) xb_add(&bar[XB_TOPGEN], 1u);
            else XB_SPIN(xb_ld(&bar[XB_TOPGEN]) == tg, bar);
            __builtin_amdgcn_fence(__ATOMIC_ACQUIRE, "agent");
            xb_add(&bar[XB_XGEN(b.x)], 1u);
            asm volatile("s_waitcnt vmcnt(0)" ::: "memory");
        } else {
            XB_SPIN(xb_ld(&bar[XB_XGEN(b.x)]) == gen, bar);
            __builtin_amdgcn_fence(__ATOMIC_ACQUIRE, "agent");
            asm volatile("s_waitcnt vmcnt(0)" ::: "memory");
        }
    }
    __syncthreads();
}

constexpr int NPHASE = 1 + NCHUNK * 2 * 4;
__global__ void __launch_bounds__(512) mega(Params p_arg, int ph_lo, int ph_hi) {
  cg::grid_group grid = cg::this_grid();
  unsigned* p_bar = ((PP)__builtin_amdgcn_kernarg_segment_ptr())->bar;
  volatile LAS unsigned* bst = (volatile LAS unsigned*)(smem + LDS_BYTES - 16);
  if (threadIdx.x < 4) bst[threadIdx.x] = 0u;
  if ((threadIdx.x & 63) == 0) *(volatile LAS int*)((LAS char*)smem + WIDTAB_OFF + hw_wave_slot() * 4) = (int)(threadIdx.x >> 6);
  __syncthreads();
  const XcdBarrier xbar = xcd_barrier_post(p_bar, bst);
#pragma unroll 1
  for (int ph = ph_lo; ph < ph_hi; ++ph) {
    if (ph > ph_lo) {
      if (ph_hi > 4096) grid.sync();
      xcd_barrier(xbar);
    }
    PP p = (PP)__builtin_amdgcn_kernarg_segment_ptr();
    asm volatile("" : "+s"(p));
    if (ph == 0) {
      int nrep = (PROBE == 6) ? 2 : 1; asm volatile("" : "+s"(nrep));
#pragma unroll 1
      for (int r = 0; r < nrep; ++r) { phase_prep(p); if (r + 1 < nrep) __syncthreads(); }
      continue;
    }
    const int q = ph - 1, kind = q & 3, cl = q >> 2, c = cl >> 1, l = cl & 1;
    const int nsub = ((PROBE == 1 || PROBE == 4 || PROBE == 5) && kind == 0) ? 2 : 1;
#pragma unroll 1
    for (int s = 0; s < nsub; ++s) {
      int kk = (s == nsub - 1) ? kind : ((PROBE == 4) ? 2 : 0);
      asm volatile("" : "+s"(kk));
      if (kk == 0) phase_g1(p, c, l, (PROBE == 5 && s < nsub - 1) ? 1 : 0);
      else if (kk == 1) phase_mix(p, c, l);
      else if (kk == 2) phase_g2(p, c, l);
      else phase_g3(p, c, l);
      if (s < nsub - 1) __syncthreads();
    }
  }
}

extern "C" void kernel_launch(void* const* d_in, const int* in_sizes, int n_in, void* d_out, int out_size, void* d_ws,
                              size_t ws_size, hipStream_t stream) {
  static int grid_blocks = 0;
  if (!grid_blocks) {
    int dev = 0, cus = 0, per_cu = 0;
    hipGetDevice(&dev);
    hipDeviceGetAttribute(&cus, hipDeviceAttributeMultiprocessorCount, dev);
    hipFuncSetAttribute((const void*)mega, hipFuncAttributeMaxDynamicSharedMemorySize, LDS_BYTES);
    hipOccupancyMaxActiveBlocksPerMultiprocessor(&per_cu, (const void*)mega, 512, LDS_BYTES);
    if (per_cu < 1) per_cu = 1;
    grid_blocks = cus * 1;
    (void)hipGetLastError();
  }
  Params p{};
  const float* const* in = (const float* const*)d_in;
  p.x = in[0]; p.mem = in[1]; p.norm_gain = in[2]; p.w_in = in[3]; p.swa_q_gain = in[4]; p.swa_k_gain = in[5];
  p.swa_sinks = in[6]; p.conv_w = in[7]; p.conv_b = in[8]; p.lru_w_a = in[9]; p.lru_b_a = in[10]; p.lru_w_x = in[11];
  p.lru_b_x = in[12]; p.lru_lambda = in[13]; p.mem_norm_gain = in[14]; p.w_mem_kv = in[15]; p.mem_q_gain = in[16];
  p.mem_k_gain = in[17]; p.w_branch = in[18]; p.w_out = in[19];
  p.out = (float*)d_out;
  char* ws = (char*)d_ws; size_t off = 0;
  auto take = [&](size_t bytes) { char* r = ws + off; off += (bytes + 255) & ~(size_t)255; return r; };
  p.bar = (unsigned*)take(XCD_BAR_WORDS * 4);
  p.lruT = (unsigned long long*)take((size_t)CB * 64 * 512 * 2 * 8);
  p.WinT = (bf16_t*)take((size_t)2 * INW * DM * 2);
  p.WbrT = (bf16_t*)take((size_t)8 * DM * 512 * 2);
  p.WoutT = (bf16_t*)take((size_t)2 * DM * DM * 2);
  p.WmkvT = (bf16_t*)take((size_t)2 * DM * DM * 2);
  p.xb = (bf16_t*)take((size_t)NTOK * DM * 2);
  p.memb = (bf16_t*)take((size_t)BATCH * 256 * DM * 2);
  p.mkv = (bf16_t*)take((size_t)2 * BATCH * 256 * DM * 2);
  p.ssq_x = (float*)take((size_t)2 * NTOK * 4);
  p.ssq_mem = (float*)take((size_t)BATCH * 256 * 4);
  p.lruA = (float*)take((size_t)CB * 64 * 512 * 4);
  p.lruH = (float*)take((size_t)CB * 64 * 512 * 4);
  p.lruWT = (bf16_t*)take((size_t)32 * 4096 * 2);
  p.xb8 = (unsigned char*)take((size_t)NTOK * DM);
  p.Wg8 = (unsigned char*)take((size_t)2 * 4096 * DM);
  p.proj = (bf16_t*)take((size_t)CT * INW * 2);
  if (off > ws_size) { fprintf(stderr, "kernel_launch: workspace too small: need %zu have %zu\n", off, ws_size); return; }
  (void)hipMemsetAsync(p.bar, 0, (size_t)((char*)p.lruT - (char*)p.bar) + (size_t)CB * 64 * 512 * 2 * 8, stream);
#if COOP
  int lo = 0, hi = NPHASE;
  void* args[] = {&p, &lo, &hi};
  hipError_t e = hipLaunchCooperativeKernel((const void*)mega, dim3(grid_blocks), dim3(512), args, LDS_BYTES, stream);
  if (e != hipSuccess) fprintf(stderr, "cooperative launch failed: %s (grid %d)\n", hipGetErrorString(e), grid_blocks);
#else
  for (int ph = 0; ph < NPHASE; ++ph) mega<<<grid_blocks, 512, LDS_BYTES, stream>>>(p, ph, ph + 1);
#endif
}
```
